# Optimizing an MI355X kernel written in HIP

```python
import math
import jax, jax.numpy as jnp
from jax import lax
import numpy as np

D_MODEL = 1024
BATCH = 8
SEQ = 2048
DEPTH = 2
DEC_BATCH = 128
DEC_SEQ = 8
PAST_LEN = 16384
PAGE_SIZE = 128

N_MIXERS = 2
N_GM_LAYERS = (DEPTH + 1) // 2
N_SSM_LAYERS = DEPTH // 2
GM_CHUNK = 128
D_GM = 2 * D_MODEL
GM_GROUPS = 8
GM_GROUP_W = D_GM // GM_GROUPS
D_INNER = 2 * D_MODEL
SSM_HEAD_DIM = 64
SSM_HEADS = D_INNER // SSM_HEAD_DIM
SSM_GROUPS = 8
HEADS_PER_GROUP = SSM_HEADS // SSM_GROUPS
D_STATE = 128
CONV_W = 4
CONV_DIM = D_INNER + 2 * SSM_GROUPS * D_STATE
D_IN_PROJ = D_INNER + CONV_DIM + SSM_HEADS
SSM_CHUNK = 128
D_FF = 4 * D_MODEL
N_MOD = 6
EPS = 1e-6

kernel_name = 'hybrid_chunkgmlp_mamba2_adaln_step'


def rms_norm(x, g):
    xf = x.astype(jnp.float32)
    y = xf * lax.rsqrt(jnp.mean(xf * xf, axis=-1, keepdims=True) + EPS)
    return (y * g.astype(jnp.float32)).astype(x.dtype)


def layer_norm(x, g, b):
    xf = x.astype(jnp.float32)
    mu = jnp.mean(xf, axis=-1, keepdims=True)
    xc = xf - mu
    y = xc * lax.rsqrt(jnp.mean(xc * xc, axis=-1, keepdims=True) + EPS)
    return (y * g.astype(jnp.float32) + b.astype(jnp.float32)).astype(x.dtype)


def modulate(h, shift, scale):
    return h * (1 + scale[:, None, :]) + shift[:, None, :]


def pad_len(a, lp):
    l = a.shape[1]
    if lp == l:
        return a
    return jnp.pad(a, [(0, 0), (0, lp - l)] + [(0, 0)] * (a.ndim - 2))


def chunk_gmlp_mixer(h, w_in, ln_g, ln_b, w_s, b_s, w_out):
    bsz, l, _ = h.shape
    z = jax.nn.gelu(h @ w_in)
    u = z[..., :D_GM]
    v = layer_norm(z[..., D_GM:], ln_g, ln_b)
    q = min(l, GM_CHUNK)
    n_chunks = -(-l // q)
    lp = n_chunks * q
    vc = pad_len(v, lp).reshape(bsz, n_chunks, q, GM_GROUPS, GM_GROUP_W)
    causal = jnp.tril(jnp.ones((q, q), dtype=bool))
    ws = jnp.where(causal[None], w_s[:, :q, :q], 0)
    s = jnp.einsum('gts,bcsgw->bctgw', ws, vc) + b_s[:, :q].T[:, :, None]
    s = s.reshape(bsz, lp, D_GM)[:, :l]
    y = (u * s) @ w_out
    start = ((l - 1) // GM_CHUNK) * GM_CHUNK
    return y, v[:, start:]


def ssd_scan(x, dt, a, bm, cm, state0):
    bsz, l = x.shape[:2]
    q = min(l, SSM_CHUNK)
    nc = -(-l // q)
    lp = nc * q
    f32 = jnp.float32
    xdt = pad_len(x.astype(f32) * dt[..., None], lp).reshape(bsz, nc, q, SSM_GROUPS, HEADS_PER_GROUP, SSM_HEAD_DIM)
    da = pad_len(dt * a, lp).reshape(bsz, nc, q, SSM_GROUPS, HEADS_PER_GROUP)
    bm = pad_len(bm.astype(f32), lp).reshape(bsz, nc, q, SSM_GROUPS, D_STATE)
    cm = pad_len(cm.astype(f32), lp).reshape(bsz, nc, q, SSM_GROUPS, D_STATE)
    acum = jnp.cumsum(da, axis=2)
    causal = jnp.tril(jnp.ones((q, q), dtype=bool))[:, :, None, None]
    seg = acum[:, :, :, None] - acum[:, :, None, :]
    decay = jnp.exp(jnp.where(causal, seg, -jnp.inf))
    cb = jnp.einsum('bctgn,bcsgn->bctsg', cm, bm)
    y_diag = jnp.einsum('bctsgr,bcsgrp->bctgrp', cb[..., None] * decay, xdt)
    decay_to_end = jnp.exp(acum[:, :, -1:] - acum)
    chunk_states = jnp.einsum('bcsgn,bcsgrp->bcgrpn', bm, xdt * decay_to_end[..., None])
    chunk_decay = jnp.exp(acum[:, :, -1])

    def step(carry, inp):
        cs, cd = inp
        return carry * cd[..., None, None] + cs, carry

    s0 = state0.astype(f32).reshape(bsz, SSM_GROUPS, HEADS_PER_GROUP, SSM_HEAD_DIM, D_STATE)
    final, entering = lax.scan(step, s0, (jnp.moveaxis(chunk_states, 1, 0), jnp.moveaxis(chunk_decay, 1, 0)))
    entering = jnp.moveaxis(entering, 0, 1)
    y_off = jnp.einsum('bctgn,bcgrpn->bctgrp', cm, entering) * jnp.exp(acum)[..., None]
    y = (y_diag + y_off).reshape(bsz, lp, SSM_HEADS, SSM_HEAD_DIM)[:, :l]
    return y, final.reshape(bsz, SSM_HEADS, SSM_HEAD_DIM, D_STATE)


def mamba2_mixer(h, conv_state, ssm_state, w_in, conv_w, conv_b, dt_bias, a_log, d_skip, norm_g, w_out):
    bsz, l, _ = h.shape
    zxbcdt = h @ w_in
    z = zxbcdt[..., :D_INNER]
    xbc = zxbcdt[..., D_INNER:D_INNER + CONV_DIM]
    dt_raw = zxbcdt[..., D_INNER + CONV_DIM:]
    xp = jnp.concatenate([conv_state.astype(xbc.dtype), xbc], axis=1)
    conv = conv_b + xp[:, 0:l] * conv_w[0]
    for k in range(1, CONV_W):
        conv = conv + xp[:, k:k + l] * conv_w[k]
    xbc_c = jax.nn.silu(conv)
    new_conv = xp[:, l:]
    xs = xbc_c[..., :D_INNER].reshape(bsz, l, SSM_HEADS, SSM_HEAD_DIM)
    bm = xbc_c[..., D_INNER:D_INNER + SSM_GROUPS * D_STATE].reshape(bsz, l, SSM_GROUPS, D_STATE)
    cm = xbc_c[..., D_INNER + SSM_GROUPS * D_STATE:].reshape(bsz, l, SSM_GROUPS, D_STATE)
    dt = jax.nn.softplus(dt_raw.astype(jnp.float32) + dt_bias.astype(jnp.float32))
    a = -jnp.exp(a_log.astype(jnp.float32))
    y, new_ssm = ssd_scan(xs, dt, a, bm, cm, ssm_state)
    y = y + xs.astype(jnp.float32) * d_skip.astype(jnp.float32)[:, None]
    y = y.reshape(bsz, l, D_INNER).astype(h.dtype) * jax.nn.silu(z)
    yg = rms_norm(y.reshape(bsz, l, SSM_GROUPS, D_INNER // SSM_GROUPS), norm_g.reshape(SSM_GROUPS, -1))
    out = yg.reshape(bsz, l, D_INNER) @ w_out
    return out, new_conv, new_ssm.astype(ssm_state.dtype)


def sq_relu_mlp(h, w1, w2):
    return jnp.square(jax.nn.relu(h @ w1)) @ w2


def trunk(x, c, ssm_states, conv_states, ada_w, ada_b, norm1_g, norm2_g,
          gm_w_in, gm_ln_g, gm_ln_b, gm_w_s, gm_b_s, gm_w_out,
          ssm_w_in, ssm_conv_w, ssm_conv_b, ssm_dt_bias, ssm_a_log, ssm_d, ssm_norm_g, ssm_w_out,
          mlp_w1, mlp_w2, final_g):
    new_v, new_conv, new_ssm = [], [], []
    for i in range(DEPTH):
        mod = (jax.nn.silu(c) @ ada_w[i] + ada_b[i]).reshape(c.shape[0], N_MOD, D_MODEL)
        h = modulate(rms_norm(x, norm1_g[i]), mod[:, 0], mod[:, 1])
        j = i // N_MIXERS
        if i % N_MIXERS == 0:
            out, v = chunk_gmlp_mixer(h, gm_w_in[j], gm_ln_g[j], gm_ln_b[j], gm_w_s[j], gm_b_s[j], gm_w_out[j])
            new_v.append(v)
        else:
            out, cs, ss = mamba2_mixer(h, conv_states[j], ssm_states[j], ssm_w_in[j], ssm_conv_w[j], ssm_conv_b[j],
                                       ssm_dt_bias[j], ssm_a_log[j], ssm_d[j], ssm_norm_g[j], ssm_w_out[j])
            new_conv.append(cs)
            new_ssm.append(ss)
        x = x + mod[:, 2][:, None, :] * out
        h = modulate(rms_norm(x, norm2_g[i]), mod[:, 3], mod[:, 4])
        x = x + mod[:, 5][:, None, :] * sq_relu_mlp(h, mlp_w1[i], mlp_w2[i])
    y = rms_norm(x, final_g)
    return y, jnp.stack(new_v), jnp.stack(new_ssm), jnp.stack(new_conv)


def setup_inputs(seed: int = 0) -> dict:
    key = jax.random.key(seed)
    ks = iter(jax.random.split(key, 40))
    f32 = jnp.float32

    def nrm(shape, scale):
        return jax.random.normal(next(ks), shape, f32) * scale

    NG, NS = N_GM_LAYERS, N_SSM_LAYERS
    dt0 = jnp.exp(jax.random.uniform(next(ks), (NS, SSM_HEADS), f32, math.log(1e-3), math.log(1e-1)))
    dt_bias = dt0 + jnp.log(-jnp.expm1(-dt0))
    a_log = jnp.log(jax.random.uniform(next(ks), (NS, SSM_HEADS), f32, 1.0, 16.0))
    return {
        'x_prompt': nrm((BATCH, SEQ, D_MODEL), 1.0),
        'x_sample': nrm((DEC_BATCH, DEC_SEQ, D_MODEL), 1.0),
        'c_prompt': nrm((BATCH, D_MODEL), 1.0),
        'c_sample': nrm((DEC_BATCH, D_MODEL), 1.0),
        'state_ssm': nrm((NS, DEC_BATCH, SSM_HEADS, SSM_HEAD_DIM, D_STATE), 0.1),
        'state_conv': nrm((NS, DEC_BATCH, CONV_W - 1, CONV_DIM), 1.0),
        'ada_w': nrm((DEPTH, D_MODEL, N_MOD * D_MODEL), D_MODEL ** -0.5),
        'ada_b': nrm((DEPTH, N_MOD * D_MODEL), 0.01),
        'norm1_g': 1.0 + nrm((DEPTH, D_MODEL), 0.02),
        'norm2_g': 1.0 + nrm((DEPTH, D_MODEL), 0.02),
        'gm_w_in': nrm((NG, D_MODEL, 2 * D_GM), D_MODEL ** -0.5),
        'gm_ln_g': 1.0 + nrm((NG, D_GM), 0.02),
        'gm_ln_b': nrm((NG, D_GM), 0.02),
        'gm_w_s': nrm((NG, GM_GROUPS, GM_CHUNK, GM_CHUNK), GM_CHUNK ** -0.5),
        'gm_b_s': 1.0 + nrm((NG, GM_GROUPS, GM_CHUNK), 0.1),
        'gm_w_out': nrm((NG, D_GM, D_MODEL), D_GM ** -0.5),
        'ssm_w_in': nrm((NS, D_MODEL, D_IN_PROJ), D_MODEL ** -0.5),
        'ssm_conv_w': nrm((NS, CONV_W, CONV_DIM), CONV_W ** -0.5),
        'ssm_conv_b': nrm((NS, CONV_DIM), 0.02),
        'ssm_dt_bias': dt_bias,
        'ssm_a_log': a_log,
        'ssm_d': 1.0 + nrm((NS, SSM_HEADS), 0.1),
        'ssm_norm_g': 1.0 + nrm((NS, D_INNER), 0.02),
        'ssm_w_out': nrm((NS, D_INNER, D_MODEL), D_INNER ** -0.5),
        'mlp_w1': nrm((DEPTH, D_MODEL, D_FF), D_MODEL ** -0.5),
        'mlp_w2': nrm((DEPTH, D_FF, D_MODEL), D_FF ** -0.5),
        'final_g': 1.0 + nrm((D_MODEL,), 0.02),
    }


def reference(x_prompt, x_sample, c_prompt, c_sample, state_ssm, state_conv, ada_w, ada_b, norm1_g, norm2_g,
              gm_w_in, gm_ln_g, gm_ln_b, gm_w_s, gm_b_s, gm_w_out,
              ssm_w_in, ssm_conv_w, ssm_conv_b, ssm_dt_bias, ssm_a_log, ssm_d, ssm_norm_g, ssm_w_out,
              mlp_w1, mlp_w2, final_g):
    weights = (ada_w, ada_b, norm1_g, norm2_g, gm_w_in, gm_ln_g, gm_ln_b, gm_w_s, gm_b_s, gm_w_out,
               ssm_w_in, ssm_conv_w, ssm_conv_b, ssm_dt_bias, ssm_a_log, ssm_d, ssm_norm_g, ssm_w_out,
               mlp_w1, mlp_w2, final_g)
    bp = x_prompt.shape[0]
    ssm0 = jnp.zeros((N_SSM_LAYERS, bp, SSM_HEADS, SSM_HEAD_DIM, D_STATE), x_prompt.dtype)
    conv0 = jnp.zeros((N_SSM_LAYERS, bp, CONV_W - 1, CONV_DIM), x_prompt.dtype)
    y_prompt, gm_v_prompt, ssm_state_prompt, conv_state_prompt = trunk(x_prompt, c_prompt, ssm0, conv0, *weights)
    y_sample, gm_v_sample, ssm_state_sample, conv_state_sample = trunk(x_sample, c_sample, state_ssm, state_conv, *weights)
    return (y_prompt, y_sample, gm_v_prompt, gm_v_sample, ssm_state_prompt, conv_state_prompt,
            ssm_state_sample, conv_state_sample)
```

```cpp
#include <hip/hip_runtime.h>
#include <hip/hip_cooperative_groups.h>
#include <cstdio>
#include <cstdint>
namespace cg = cooperative_groups;
namespace pg8 {
#define PG8_LAS __attribute__((address_space(3)))
typedef unsigned short bf16_t;
typedef short bf16x8 __attribute__((ext_vector_type(8)));
typedef float f32x4 __attribute__((ext_vector_type(4)));
typedef unsigned u32x4 __attribute__((ext_vector_type(4)));
constexpr int BM = 256, BK = 64, HALF = 128, HTB = HALF * BK * 2  , STAGE_BYTES = 8 * HTB, NXCD = 8, WGM = 8;

__host__ __device__ __forceinline__ int lds_byte(int r, int c) { const int st = (r >> 4) * 2 + (c >> 5), rr = r & 15, cc = c & 31, ob = rr * 64 + cc * 2; return st * 1024 + (ob ^ (((ob >> 9) & 1) << 5)); }
__host__ __device__ __forceinline__ void stage_rc(int b, int& R, int& C) { const int st = b / 1024, sb = b % 1024, swz = sb ^ (((sb >> 9) & 1) << 5); R = (st >> 1) * 16 + swz / 64; C = (st & 1) * 32 + (swz % 64) / 2; }
__host__ __device__ __forceinline__ int perm32(int rho) { const int n = rho >> 4, i = rho & 15; return 8 * (i >> 2) + 4 * n + (i & 3); }

struct Unit { int pm, pn, ks; };
struct Gemm { const bf16_t* A; const bf16_t* Bt; int M, N, K, ld; };

struct StaticOrder {
    int nM, nN, nwg, G, c, pm0, nsplit;
    __host__ __device__ void init(int M, int N, int G_, int c_, int pm0_ = 0, int nsplit_ = 1) { nM = M / BM; nN = N / BM; nwg = nM * nN; G = G_; c = c_; pm0 = pm0_; nsplit = nsplit_; }
    __host__ __device__ bool next(int i, Unit& u) const {
        const long L = (long)i * G + c; if (L >= (long)nwg * nsplit) return false;
        if (nsplit > 1) { const int ti = (int)L % nwg; u.ks = (int)L / nwg; u.pm = pm0 + ti % nM; u.pn = ti / nM; return true; }
        int wgid = (int)L; { const int q = nwg / NXCD, r = nwg % NXCD, xcd = wgid % NXCD, off = wgid / NXCD; wgid = (xcd < r ? xcd * (q + 1) : r * (q + 1) + (xcd - r) * q) + off; }
        const int nig = WGM * nN, gid = wgid / nig, fm = gid * WGM, gsz = (nM - fm) < WGM ? (nM - fm) : WGM;
        u.pm = pm0 + fm + ((wgid % nig) % gsz); u.pn = (wgid % nig) / gsz; u.ks = 0; return true;
    }
    __device__ __forceinline__ void a_ready(const Unit&) const {}
    __device__ __forceinline__ void done(const Unit&) const {}
};
__device__ __forceinline__ unsigned cvt_pk_bf16(float lo, float hi) { unsigned r; asm volatile("v_cvt_pk_bf16_f32 %0, %1, %2" : "=v"(r) : "v"(lo), "v"(hi)); return r; }
typedef float f32x2 __attribute__((ext_vector_type(2)));
constexpr int EPI_TP = 16384;
__device__ __forceinline__ void act_gelu_tanh8(f32x2 (&x)[4]) {
    f32x2 t[4];
#pragma unroll
    for (int j = 0; j < 4; ++j) t[j] = x[j] * x[j];
#pragma unroll
    for (int j = 0; j < 4; ++j) t[j] = t[j] * (-2.3022082f * 0.044715f) + (-2.3022082f);
#pragma unroll
    for (int j = 0; j < 4; ++j) t[j] = t[j] * x[j];
#pragma unroll
    for (int j = 0; j < 4; ++j) { t[j].x = __builtin_amdgcn_exp2f(t[j].x); t[j].y = __builtin_amdgcn_exp2f(t[j].y); }
#pragma unroll
    for (int j = 0; j < 4; ++j) t[j] = t[j] + 1.0f;
#pragma unroll
    for (int j = 0; j < 4; ++j) { t[j].x = __builtin_amdgcn_rcpf(t[j].x); t[j].y = __builtin_amdgcn_rcpf(t[j].y); }
#pragma unroll
    for (int j = 0; j < 4; ++j) x[j] = x[j] * t[j];
}
struct EpiGen {
    static constexpr bool PERM = true, AFTER_DRAIN = false;
    int mode;
    int act;
    bf16_t* O; int ldc;
    float* F;
    const float* aux;
    float* aux2;
    __device__ __forceinline__ void operator()(const f32x4 (&acc)[2][2][4][2], const Unit& u, int wr, int wc, int fr, int fq) const {
        const int row0 = u.pm * BM + wr * 64 + fr;
        const int col0 = u.pn * BM + wc * 32 + 8 * fq;
        const int md = mode & 15;
        if (md == 0) {
            const bool dtt = (mode & 32) && (u.pn == 24);
            const bool st = (mode & 16) && (u.pn >= 8);
#pragma unroll
            for (int ai = 0; ai < 2; ++ai)
#pragma unroll
                for (int m = 0; m < 4; ++m) {
                    const int row = row0 + ai * HALF + m * 16;
                    float s = 0.f, q = 0.f;
#pragma unroll
                    for (int bj = 0; bj < 2; ++bj) {
                        f32x4 v0 = acc[ai][bj][m][0], v1 = acc[ai][bj][m][1];
                        if (act == 1) {
                            { f32x2 p[4] = {(f32x2){v0[0], v0[1]}, (f32x2){v0[2], v0[3]}, (f32x2){v1[0], v1[1]}, (f32x2){v1[2], v1[3]}}; act_gelu_tanh8(p);
                              v0 = (f32x4){p[0].x, p[0].y, p[1].x, p[1].y}; v1 = (f32x4){p[2].x, p[2].y, p[3].x, p[3].y}; }
                        } else if (act == 2) {
#pragma unroll
                            for (int e = 0; e < 4; ++e) { const float a = v0[e] > 0.f ? v0[e] : 0.f, b = v1[e] > 0.f ? v1[e] : 0.f; v0[e] = a * a; v1[e] = b * b; }
                        }
                        if (dtt) {
                            if (bj == 0 && wc == 0) { float* d = aux2 + (size_t)row * 32 + 8 * fq; *(f32x4*)d = v0; *(f32x4*)(d + 4) = v1; }
                        } else {
                            u32x4 w; w.x = cvt_pk_bf16(v0[0], v0[1]); w.y = cvt_pk_bf16(v0[2], v0[3]); w.z = cvt_pk_bf16(v1[0], v1[1]); w.w = cvt_pk_bf16(v1[2], v1[3]);
                            *(u32x4*)(O + (size_t)row * ldc + col0 + bj * HALF) = w;
                        }
                        if (st) {
#pragma unroll
                            for (int e = 0; e < 4; ++e) { s += v0[e] + v1[e]; q += v0[e] * v0[e] + v1[e] * v1[e]; }
                        }
                    }
                    if (st) {
                        s += __shfl_xor(s, 16); s += __shfl_xor(s, 32); q += __shfl_xor(q, 16); q += __shfl_xor(q, 32);
                        if (fq == 0) { atomicAdd(aux2 + 2 * (size_t)row, s); atomicAdd(aux2 + 2 * (size_t)row + 1, q); }
                    }
                }
        } else if (md == 1 || md == 3 || md == 5) {
#pragma unroll
            for (int ai = 0; ai < 2; ++ai)
#pragma unroll
                for (int m = 0; m < 4; ++m) {
                    const int row = row0 + ai * HALF + m * 16;
                    const int seq = row < EPI_TP ? (row >> 11) : 8 + ((row - EPI_TP) >> 3);
                    const float* gr = aux + (size_t)seq * 12288;
                    float* fo = F + (size_t)row * 1024;
#pragma unroll
                    for (int bj = 0; bj < 2; ++bj) {
                        const int c = col0 + bj * HALF;
                        const f32x4 g0 = *(const f32x4*)(gr + c), g1 = *(const f32x4*)(gr + c + 4);
                        if (md != 3) {
                            const float* bo = md == 5 ? aux2 + (size_t)row * 1024 : fo;
                            const f32x4 b0 = *(const f32x4*)(bo + c), b1 = *(const f32x4*)(bo + c + 4);
                            *(f32x4*)(fo + c) = b0 + g0 * acc[ai][bj][m][0];
                            *(f32x4*)(fo + c + 4) = b1 + g1 * acc[ai][bj][m][1];
                        } else {
                            float* po = F + ((size_t)u.ks * 1024 + (row - EPI_TP)) * 1024 + c;
                            *(f32x4*)po = g0 * acc[ai][bj][m][0];
                            *(f32x4*)(po + 4) = g1 * acc[ai][bj][m][1];
                        }
                    }
                }
        } else {
#pragma unroll
            for (int ai = 0; ai < 2; ++ai)
#pragma unroll
                for (int m = 0; m < 4; ++m) {
                    const int row = row0 + ai * HALF + m * 16;
                    float* fo = F + (size_t)row * 12288;
#pragma unroll
                    for (int bj = 0; bj < 2; ++bj) {
                        const int c = col0 + bj * HALF;
                        const f32x4 b0 = *(const f32x4*)(aux + c), b1 = *(const f32x4*)(aux + c + 4);
                        *(f32x4*)(fo + c) = b0 + acc[ai][bj][m][0];
                        *(f32x4*)(fo + c + 4) = b1 + acc[ai][bj][m][1];
                    }
                }
        }
    }
};

template <class Epi, class Sched, bool ALIGN_EPI = false, bool SP2 = false>
__device__ __forceinline__ void gemm_phase(PG8_LAS unsigned char* lds, const Gemm g, const Sched& S, const Epi& E) {
    int tid_ = threadIdx.x; asm volatile("" : "+v"(tid_));
    const int tid = tid_, wid = __builtin_amdgcn_readfirstlane(tid >> 6), lane = tid & 63, wr = wid >> 2, wc = wid & 3, fr = lane & 15, fq = lane >> 4;
    const int K = g.ld, nt = g.K / BK;
    unsigned voffA[2], voffB[2];
#pragma unroll
    for (int i = 0; i < 2; ++i) { int R, C; stage_rc(tid * 16 + i * 8192, R, C); const int Rb = Epi::PERM ? ((R & ~31) + perm32(R & 31)) : R;
        voffA[i] = (unsigned)(R * K + C) * 2u; voffB[i] = (unsigned)(Rb * K + C) * 2u; }
    const size_t kstep = (size_t)(BK * 2);
    const size_t hstep = (size_t)HALF * K * 2;
    const size_t tstep = 2 * hstep;
    const unsigned ldsw = (unsigned)wid * 1024u;
    const int aoff = lds_byte(wr * 64 + fr, fq * 8), boff = lds_byte(wc * 32 + fr, fq * 8);
#define PG8_SA(b, h) (((b) * 2 + (h)) * HTB)
#define PG8_SB(b, h) ((4 + (b) * 2 + (h)) * HTB)
#define PG8_STAGE(bufoff, gbase, voff) do { _Pragma("unroll") for (int _i = 0; _i < 2; ++_i) \
        __builtin_amdgcn_global_load_lds((const unsigned*)((const char*)(gbase) + (voff)[_i]), (PG8_LAS unsigned*)(lds + (bufoff) + ldsw + _i * 8192), 16, 0, 0); } while (0)
#define PG8_LDA(dst, b, h) do { _Pragma("unroll") for (int m = 0; m < 4; ++m) _Pragma("unroll") for (int k = 0; k < 2; ++k) dst[m][k] = *(const PG8_LAS bf16x8*)(lds + PG8_SA(b, h) + aoff + m * 2048 + k * 1024); } while (0)
#define PG8_LDB(dst, b, h) do { _Pragma("unroll") for (int n = 0; n < 2; ++n) _Pragma("unroll") for (int k = 0; k < 2; ++k) dst[n][k] = *(const PG8_LAS bf16x8*)(lds + PG8_SB(b, h) + boff + n * 2048 + k * 1024); } while (0)
#define PG8_MMA(ai, bj, At, Bt) do { __builtin_amdgcn_s_setprio(1); _Pragma("unroll") for (int m = 0; m < 4; ++m) _Pragma("unroll") for (int n = 0; n < 2; ++n) _Pragma("unroll") for (int k = 0; k < 2; ++k) \
        acc[ai][bj][m][n] = __builtin_amdgcn_mfma_f32_16x16x32_bf16(Bt[n][k], At[m][k], acc[ai][bj][m][n], 0, 0, 0); __builtin_amdgcn_s_setprio(0); } while (0)
#define PG8_WAIT_V(n) asm volatile("s_waitcnt vmcnt(" #n ")" ::: "memory")
#define PG8_WAIT_L(n) asm volatile("s_waitcnt lgkmcnt(" #n ")" ::: "memory")
#define PG8_BAR __builtin_amdgcn_s_barrier()
#define PG8_SCHED __builtin_amdgcn_sched_barrier(0)
    Unit cur, nxt; int ui = 0;
    if (!S.next(0, cur)) return;
    f32x4 acc[2][2][4][2];
#pragma unroll
    for (int a = 0; a < 2; ++a)
#pragma unroll
        for (int b = 0; b < 2; ++b)
#pragma unroll
            for (int m = 0; m < 4; ++m)
#pragma unroll
                for (int n = 0; n < 2; ++n) acc[a][b][m][n] = (f32x4){0.f, 0.f, 0.f, 0.f};
    bf16x8 At[4][2], B0[2][2], B1[2][2];
    const size_t ksb = (size_t)g.K * 2;
    const char* cA = (const char*)g.A + (size_t)cur.pm * tstep + cur.ks * ksb; const char* cB = (const char*)g.Bt + (size_t)cur.pn * tstep + cur.ks * ksb;
    S.a_ready(cur);
    if constexpr (SP2) {
        PG8_STAGE(PG8_SB(0, 0), cB, voffB); PG8_STAGE(PG8_SB(0, 1), cB + hstep, voffB); PG8_STAGE(PG8_SA(0, 0), cA, voffA); PG8_STAGE(PG8_SA(0, 1), cA + hstep, voffA);
        if (wr == 1) PG8_BAR;
        PG8_WAIT_V(2); PG8_BAR;
        PG8_STAGE(PG8_SB(1, 0), cB + kstep, voffB); PG8_STAGE(PG8_SA(1, 0), cA + kstep, voffA); PG8_STAGE(PG8_SB(1, 1), cB + hstep + kstep, voffB);
        PG8_WAIT_V(6); PG8_BAR;
    } else {
        PG8_STAGE(PG8_SB(0, 0), cB, voffB); PG8_STAGE(PG8_SA(0, 0), cA, voffA); PG8_STAGE(PG8_SB(0, 1), cB + hstep, voffB); PG8_STAGE(PG8_SA(0, 1), cA + hstep, voffA);
        if (wr == 1) PG8_BAR;
        PG8_WAIT_V(4); PG8_BAR;
        PG8_STAGE(PG8_SB(1, 0), cB + kstep, voffB); PG8_STAGE(PG8_SA(1, 0), cA + kstep, voffA); PG8_STAGE(PG8_SB(1, 1), cB + hstep + kstep, voffB);
        PG8_WAIT_V(6); PG8_BAR;
    }
    for (;;) {
        const bool has_next = S.next(ui + 1, nxt);
        const char* nA = has_next ? (const char*)g.A + (size_t)nxt.pm * tstep + nxt.ks * ksb : cA; const char* nB = has_next ? (const char*)g.Bt + (size_t)nxt.pn * tstep + nxt.ks * ksb : cB;
        for (int t = 0; t < nt; t += 2) {
            const bool last = (t == nt - 2);
            const char* a1 = cA + (size_t)(t + 1) * kstep;
            const char* a2 = last ? nA : cA + (size_t)(t + 2) * kstep; const char* b2 = last ? nB : cB + (size_t)(t + 2) * kstep;
            const char* a3 = a2 + kstep; const char* b3 = b2 + kstep;
            if (last && has_next) S.a_ready(nxt);
            if constexpr (SP2) {
            PG8_LDB(B0, 0, 0); PG8_LDB(B1, 0, 1); PG8_SCHED; PG8_LDA(At, 0, 0); PG8_STAGE(PG8_SA(1, 1), a1 + hstep, voffA);
            PG8_WAIT_V(8); PG8_WAIT_L(0); PG8_BAR; PG8_MMA(0, 0, At, B0); PG8_MMA(0, 1, At, B1); PG8_BAR; PG8_SCHED;
            PG8_LDA(At, 0, 1); PG8_STAGE(PG8_SB(0, 0), b2, voffB); PG8_STAGE(PG8_SB(0, 1), b2 + hstep, voffB); PG8_STAGE(PG8_SA(0, 0), a2, voffA);
            PG8_WAIT_V(8); PG8_WAIT_L(0); PG8_BAR; PG8_MMA(1, 0, At, B0); PG8_MMA(1, 1, At, B1); PG8_BAR; PG8_SCHED;
            PG8_LDB(B0, 1, 0); PG8_LDB(B1, 1, 1); PG8_SCHED; PG8_LDA(At, 1, 0); PG8_STAGE(PG8_SA(0, 1), a2 + hstep, voffA);
            PG8_WAIT_V(8); PG8_WAIT_L(0); PG8_BAR; PG8_MMA(0, 0, At, B0); PG8_MMA(0, 1, At, B1); PG8_BAR; PG8_SCHED;
            PG8_LDA(At, 1, 1); PG8_STAGE(PG8_SB(1, 0), b3, voffB); PG8_STAGE(PG8_SB(1, 1), b3 + hstep, voffB); PG8_STAGE(PG8_SA(1, 0), a3, voffA);
            PG8_WAIT_V(8); PG8_WAIT_L(0); PG8_BAR; PG8_MMA(1, 0, At, B0); PG8_MMA(1, 1, At, B1); PG8_BAR; PG8_SCHED;
            } else {
            PG8_LDB(B0, 0, 0); PG8_SCHED; PG8_LDA(At, 0, 0); PG8_STAGE(PG8_SA(1, 1), a1 + hstep, voffA);
            PG8_WAIT_L(8); PG8_BAR; PG8_WAIT_L(0); PG8_MMA(0, 0, At, B0); PG8_BAR; PG8_SCHED;
            PG8_LDB(B1, 0, 1); PG8_STAGE(PG8_SB(0, 0), b2, voffB);
            PG8_BAR; PG8_WAIT_L(0); PG8_MMA(0, 1, At, B1); PG8_BAR;
            PG8_LDA(At, 0, 1); PG8_STAGE(PG8_SA(0, 0), a2, voffA);
            PG8_BAR; PG8_WAIT_L(0); PG8_MMA(1, 0, At, B0); PG8_BAR; PG8_SCHED;
            PG8_STAGE(PG8_SB(0, 1), b2 + hstep, voffB);
            PG8_WAIT_V(6); PG8_BAR; PG8_MMA(1, 1, At, B1); PG8_BAR;
            PG8_LDB(B0, 1, 0); PG8_SCHED; PG8_LDA(At, 1, 0); PG8_STAGE(PG8_SA(0, 1), a2 + hstep, voffA);
            PG8_WAIT_L(8); PG8_BAR; PG8_WAIT_L(0); PG8_MMA(0, 0, At, B0); PG8_BAR; PG8_SCHED;
            PG8_LDB(B1, 1, 1); PG8_STAGE(PG8_SB(1, 0), b3, voffB);
            PG8_BAR; PG8_WAIT_L(0); PG8_MMA(0, 1, At, B1); PG8_BAR;
            PG8_LDA(At, 1, 1); PG8_STAGE(PG8_SA(1, 0), a3, voffA);
            PG8_BAR; PG8_WAIT_L(0); PG8_MMA(1, 0, At, B0); PG8_BAR; PG8_SCHED;
            PG8_STAGE(PG8_SB(1, 1), b3 + hstep, voffB);
            PG8_WAIT_V(6); PG8_BAR; PG8_MMA(1, 1, At, B1); PG8_BAR;
            }
        }
        if constexpr (ALIGN_EPI) { if (wr == 0) PG8_BAR; }
        if constexpr (!Epi::AFTER_DRAIN) { E(acc, cur, wr, wc, fr, fq); S.done(cur); }
        if (!has_next) break;
#pragma unroll
        for (int a = 0; a < 2; ++a)
#pragma unroll
            for (int b = 0; b < 2; ++b)
#pragma unroll
                for (int m = 0; m < 4; ++m)
#pragma unroll
                    for (int n = 0; n < 2; ++n) acc[a][b][m][n] = (f32x4){0.f, 0.f, 0.f, 0.f};
        cur = nxt; cA = nA; cB = nB; ++ui;
        if constexpr (ALIGN_EPI) { if (wr == 1) PG8_BAR; }
    }
    PG8_WAIT_V(0);
    if constexpr (!ALIGN_EPI) { if (wr == 0) PG8_BAR; }
    PG8_BAR;
    if constexpr (Epi::AFTER_DRAIN) { E.fused(acc, cur, wr, wc, fr, fq, lds, wid, lane); S.done(cur); }
#undef PG8_SA
#undef PG8_SB
#undef PG8_STAGE
#undef PG8_LDA
#undef PG8_LDB
#undef PG8_MMA
#undef PG8_WAIT_V
#undef PG8_WAIT_L
#undef PG8_BAR
#undef PG8_SCHED
}
}

#define LAS __attribute__((address_space(3)))
typedef unsigned short bf16;
typedef unsigned v4u __attribute__((ext_vector_type(4)));
typedef unsigned v2u __attribute__((ext_vector_type(2)));
typedef float f32x4 __attribute__((ext_vector_type(4)));
typedef float f32x2 __attribute__((ext_vector_type(2)));
typedef short bf16x8 __attribute__((ext_vector_type(8)));
typedef LAS unsigned char* ldsp;

constexpr int NWAVES = 8, NTHR = 512;
constexpr int D = 1024, TP = 16384, TS = 1024, T = TP + TS, NSEQ = 136;
constexpr int DGM = 2048, DIN = 2048, CONVD = 4096, NPROJ = 6176, NPROJ_PAD = 6400, ZXP = 6144, DFF = 4096, NMODC = 12288;
constexpr float EPS = 1e-6f;
constexpr int LDS_BYTES = 163840;

constexpr size_t MiB = 1u << 20;
constexpr size_t WS_WADA = 0;
constexpr size_t WS_WGIN = WS_WADA + 24 * MiB;
constexpr size_t WS_WGOUT = WS_WGIN + 8 * MiB;
constexpr size_t WS_WSIN = WS_WGOUT + 4 * MiB;
constexpr size_t WS_WSOUT = WS_WSIN + 13 * MiB;
constexpr size_t WS_WM1 = WS_WSOUT + 4 * MiB;
constexpr size_t WS_WM2 = WS_WM1 + 16 * MiB;
constexpr size_t WS_CS = WS_WM2 + 16 * MiB;
constexpr size_t WS_MOD = WS_CS + 1 * MiB;
constexpr size_t WS_H = WS_MOD + 12 * MiB;
constexpr size_t WS_BIG = WS_H + 34 * MiB;
constexpr size_t WS_G = WS_BIG + 204 * MiB;
constexpr size_t WS_DT = WS_G + 68 * MiB;
constexpr size_t WS_STATS = WS_DT + 3 * MiB;
constexpr size_t WS_SS = WS_STATS + 1 * MiB;
constexpr size_t WS_CTL = WS_SS + 3 * MiB;
constexpr size_t CTL_BYTES = 16384;
constexpr size_t WS_PART = WS_CTL + 1 * MiB;
constexpr int NSPLIT = 8;
constexpr size_t WS_END = WS_PART + 32 * MiB;
constexpr int MISC_OFF = LDS_BYTES - 64;

constexpr size_t O_Y = 0;
constexpr size_t O_VP = (size_t)T * D;
constexpr size_t O_VS = O_VP + (size_t)8 * 128 * 2048;
constexpr size_t O_SP = O_VS + (size_t)128 * 8 * 2048;
constexpr size_t O_CP = O_SP + (size_t)8 * 32 * 64 * 128;
constexpr size_t O_SSS = O_CP + (size_t)8 * 3 * 4096;
constexpr size_t O_CSS = O_SSS + (size_t)128 * 32 * 64 * 128;
constexpr size_t O_END = O_CSS + (size_t)128 * 3 * 4096;

struct Args { const float* in[27]; float* out; unsigned char* ws; int ph_lo, ph_hi; };
typedef const __attribute__((address_space(4))) Args CArgs;

#define LDS_WAIT() asm volatile("s_waitcnt lgkmcnt(0)" ::: "memory")
#define LDS_BARRIER() do { asm volatile("s_waitcnt lgkmcnt(0)" ::: "memory"); __builtin_amdgcn_s_barrier(); asm volatile("" ::: "memory"); } while (0)
__device__ __forceinline__ unsigned f2bf(float f) { unsigned u = __builtin_bit_cast(unsigned, f); return (u + 0x7fffu + ((u >> 16) & 1u)) >> 16; }
__device__ __forceinline__ unsigned pk2(float lo, float hi) { unsigned r; asm("v_cvt_pk_bf16_f32 %0, %1, %2" : "=v"(r) : "v"(lo), "v"(hi)); return r; }
__device__ __forceinline__ float bf_lo(unsigned w) { return __builtin_bit_cast(float, w << 16); }
__device__ __forceinline__ float bf_hi(unsigned w) { return __builtin_bit_cast(float, w & 0xffff0000u); }
__device__ __forceinline__ float bf1(bf16 b) { return __builtin_bit_cast(float, (unsigned)b << 16); }
__device__ __forceinline__ float wave_sum(float v) {
#pragma unroll
    for (int o = 1; o < 64; o <<= 1) v += __shfl_xor(v, o);
    return v;
}
__device__ __forceinline__ float silu_f(float x) { return x * __builtin_amdgcn_rcpf(1.0f + __builtin_amdgcn_exp2f(-1.4426950409f * x)); }
__device__ __forceinline__ float exp_f(float x) { return __builtin_amdgcn_exp2f(1.4426950409f * x); }
__device__ __forceinline__ float softplus_f(float x) { return x > 20.f ? x : 0.6931471806f * __builtin_amdgcn_logf(1.0f + __builtin_amdgcn_exp2f(1.4426950409f * x)); }
__device__ __forceinline__ int seq_of_row(int row) { return row < TP ? (row >> 11) : 8 + ((row - TP) >> 3); }

__device__ __forceinline__ void p0_transpose_item(const float* W, int K, int N, bf16* WT, int row_off, const float* kscale, LAS float* scr, int item, int lane) {
    const int nblk = N / 32, kb = item / nblk, nb = item % nblk, k0 = 64 * kb, n0 = 32 * nb;
#pragma unroll 8
    for (int i = 0; i < 32; ++i) { const int kk = 2 * i + (lane >> 5); float v = W[(size_t)(k0 + kk) * N + n0 + (lane & 31)]; if (kscale) v *= kscale[k0 + kk]; scr[kk * 33 + (lane & 31)] = v; }
    LDS_WAIT(); asm volatile("" ::: "memory");
    const int c = lane & 7;
#pragma unroll
    for (int j = 0; j < 4; ++j) { const int n = (lane >> 3) + 8 * j; const LAS float* s = scr + (8 * c) * 33 + n;
        v4u o; o.x = pk2(s[0 * 33], s[1 * 33]); o.y = pk2(s[2 * 33], s[3 * 33]); o.z = pk2(s[4 * 33], s[5 * 33]); o.w = pk2(s[6 * 33], s[7 * 33]);
        *(v4u*)(WT + (size_t)(row_off + n0 + n) * K + k0 + 8 * c) = o; }
    LDS_WAIT(); asm volatile("" ::: "memory");
}

__device__ __forceinline__ void p0_prologue(CArgs& a, ldsp lds, int gw, int NGW, int wave, int lane) {
    unsigned char* ws = a.ws;
    LAS float* scr = (LAS float*)(lds + wave * 16384);
    constexpr int I_ADA = 16 * 192, I_GIN = 16 * 128, I_GOUT = 32 * 32, I_SIN = 16 * 193, I_SOUT = 32 * 32, I_M1 = 16 * 128, I_M2 = 64 * 32;
    constexpr int NITEMS = 2 * I_ADA + I_GIN + I_GOUT + I_SIN + I_SOUT + 2 * I_M1 + 2 * I_M2;
    for (int it = gw; it < NITEMS; it += NGW) {
        int r = it;
        if (r < I_ADA) { p0_transpose_item(a.in[6], 1024, 6144, (bf16*)(ws + WS_WADA), 0, nullptr, scr, r, lane); continue; } r -= I_ADA;
        if (r < I_ADA) { p0_transpose_item(a.in[6] + (size_t)1024 * 6144, 1024, 6144, (bf16*)(ws + WS_WADA), 6144, nullptr, scr, r, lane); continue; } r -= I_ADA;
        if (r < I_GIN) { p0_transpose_item(a.in[10], 1024, 4096, (bf16*)(ws + WS_WGIN), 0, nullptr, scr, r, lane); continue; } r -= I_GIN;
        if (r < I_GOUT) { p0_transpose_item(a.in[15], 2048, 1024, (bf16*)(ws + WS_WGOUT), 0, nullptr, scr, r, lane); continue; } r -= I_GOUT;
        if (r < I_SIN) { p0_transpose_item(a.in[16], 1024, NPROJ, (bf16*)(ws + WS_WSIN), 0, nullptr, scr, r, lane); continue; } r -= I_SIN;
        if (r < I_SOUT) { p0_transpose_item(a.in[23], 2048, 1024, (bf16*)(ws + WS_WSOUT), 0, a.in[22], scr, r, lane); continue; } r -= I_SOUT;
        if (r < I_M1) { p0_transpose_item(a.in[24], 1024, 4096, (bf16*)(ws + WS_WM1), 0, nullptr, scr, r, lane); continue; } r -= I_M1;
        if (r < I_M1) { p0_transpose_item(a.in[24] + (size_t)1024 * 4096, 1024, 4096, (bf16*)(ws + WS_WM1), 4096, nullptr, scr, r, lane); continue; } r -= I_M1;
        if (r < I_M2) { p0_transpose_item(a.in[25], 4096, 1024, (bf16*)(ws + WS_WM2), 0, nullptr, scr, r, lane); continue; } r -= I_M2;
        p0_transpose_item(a.in[25] + (size_t)4096 * 1024, 4096, 1024, (bf16*)(ws + WS_WM2), 1024, nullptr, scr, r, lane);
    }
    for (int s = gw; s < 256; s += NGW) {
        bf16* o = (bf16*)(ws + WS_CS) + (size_t)s * 1024;
        const float* c = s < 8 ? a.in[2] + (size_t)s * 1024 : a.in[3] + (size_t)(s - 8) * 1024;
#pragma unroll
        for (int j = 0; j < 4; ++j) {
            const int col = lane * 4 + 256 * j; v2u w; w.x = 0u; w.y = 0u;
            if (s < NSEQ) { const f32x4 v = *(const f32x4*)(c + col); w.x = pk2(silu_f(v[0]), silu_f(v[1])); w.y = pk2(silu_f(v[2]), silu_f(v[3])); }
            *(v2u*)(o + col) = w;
        }
    }
    { float* st = (float*)(ws + WS_STATS); for (int i = gw * 64 + lane; i < T * 2; i += NGW * 64) st[i] = 0.f; }
    { v4u* p = (v4u*)((bf16*)(ws + WS_WSIN) + (size_t)NPROJ * 1024); const int n = (NPROJ_PAD - NPROJ) * 1024 / 8; const v4u z = {0u, 0u, 0u, 0u};
      for (int i = gw * 64 + lane; i < n; i += NGW * 64) p[i] = z; }
}

__device__ __forceinline__ void normmod_phase(const float* x0, const float* x1, const float* gamma, const float* shift, const float* scale, bf16* H, float* xcopy, const float* part, int gw, int NGW, int lane) {
    int row = gw; if (row >= T) return;
    f32x4 gm4[4];
#pragma unroll
    for (int j = 0; j < 4; ++j) gm4[j] = *(const f32x4*)(gamma + lane * 4 + 256 * j);
    f32x4 v[4], sc[4], sh[4];
    {
        const float* xr = row < TP ? x0 + (size_t)row * D : x1 + (size_t)(row - TP) * D; const int seq = seq_of_row(row);
#pragma unroll
        for (int j = 0; j < 4; ++j) { const int c = lane * 4 + 256 * j; v[j] = *(const f32x4*)(xr + c); sc[j] = *(const f32x4*)(scale + (size_t)seq * NMODC + c); sh[j] = *(const f32x4*)(shift + (size_t)seq * NMODC + c); }
    }
    for (; row < T; row += NGW) {
        const int nrow = row + NGW;
        f32x4 vn[4], scn[4], shn[4];
        if (nrow < T) {
            const float* xn = nrow < TP ? x0 + (size_t)nrow * D : x1 + (size_t)(nrow - TP) * D; const int seqn = seq_of_row(nrow);
#pragma unroll
            for (int j = 0; j < 4; ++j) { const int c = lane * 4 + 256 * j; vn[j] = *(const f32x4*)(xn + c); scn[j] = *(const f32x4*)(scale + (size_t)seqn * NMODC + c); shn[j] = *(const f32x4*)(shift + (size_t)seqn * NMODC + c); }
        } else {
#pragma unroll
            for (int j = 0; j < 4; ++j) { vn[j] = v[j]; scn[j] = sc[j]; shn[j] = sh[j]; }
        }
        float ss = 0.f;
        if (part && row >= TP) {
            float* xw = const_cast<float*>(x1) + (size_t)(row - TP) * D;
#pragma unroll
            for (int j = 0; j < 4; ++j) {
#pragma unroll
                for (int k = 0; k < NSPLIT; ++k) v[j] += *(const f32x4*)(part + ((size_t)k * 1024 + (row - TP)) * 1024 + lane * 4 + 256 * j);
                *(f32x4*)(xw + lane * 4 + 256 * j) = v[j];
            }
        }
#pragma unroll
        for (int j = 0; j < 4; ++j) ss += (v[j][0] * v[j][0] + v[j][1] * v[j][1]) + (v[j][2] * v[j][2] + v[j][3] * v[j][3]);
        if (xcopy && row >= TP) {
#pragma unroll
            for (int j = 0; j < 4; ++j) *(f32x4*)(xcopy + (size_t)row * D + lane * 4 + 256 * j) = v[j];
        }
        const float rstd = 1.0f / sqrtf(wave_sum(ss) * (1.0f / D) + EPS);
#pragma unroll
        for (int j = 0; j < 4; ++j) {
            const int c = lane * 4 + 256 * j;
            const f32x4 o = v[j] * rstd * gm4[j] * (1.0f + sc[j]) + sh[j];
            v2u w; w.x = pk2(o[0], o[1]); w.y = pk2(o[2], o[3]);
            *(v2u*)(H + (size_t)row * D + c) = w;
        }
#pragma unroll
        for (int j = 0; j < 4; ++j) { v[j] = vn[j]; sc[j] = scn[j]; sh[j] = shn[j]; }
    }
}
__device__ __forceinline__ void finalnorm_phase(float* x, const float* gamma, const float* part, int gw, int NGW, int lane) {
    int row = gw; if (row >= T) return;
    f32x4 gm4[4], v[4];
#pragma unroll
    for (int j = 0; j < 4; ++j) { gm4[j] = *(const f32x4*)(gamma + lane * 4 + 256 * j); v[j] = *(const f32x4*)(x + (size_t)row * D + lane * 4 + 256 * j); }
    for (; row < T; row += NGW) {
        float* xr = x + (size_t)row * D;
        const int nrow = row + NGW; f32x4 vn[4];
#pragma unroll
        for (int j = 0; j < 4; ++j) vn[j] = nrow < T ? *(const f32x4*)(x + (size_t)nrow * D + lane * 4 + 256 * j) : v[j];
        if (part && row >= TP) {
#pragma unroll
            for (int j = 0; j < 4; ++j) {
#pragma unroll
                for (int k = 0; k < NSPLIT; ++k) v[j] += *(const f32x4*)(part + ((size_t)k * 1024 + (row - TP)) * 1024 + lane * 4 + 256 * j);
            }
        }
        float ss = 0.f;
#pragma unroll
        for (int j = 0; j < 4; ++j) ss += (v[j][0] * v[j][0] + v[j][1] * v[j][1]) + (v[j][2] * v[j][2] + v[j][3] * v[j][3]);
        const float rstd = 1.0f / sqrtf(wave_sum(ss) * (1.0f / D) + EPS);
#pragma unroll
        for (int j = 0; j < 4; ++j) { const int c = lane * 4 + 256 * j; __builtin_nontemporal_store(v[j] * rstd * gm4[j], (f32x4*)(xr + c)); }
#pragma unroll
        for (int j = 0; j < 4; ++j) v[j] = vn[j];
    }
}
__device__ __forceinline__ void groupnorm_phase(bf16* G, const float* SS, int gw, int NGW, int lane) {
    int row = gw; if (row >= T) return;
    v4u w[4]; f32x4 s4[4];
#pragma unroll
    for (int j = 0; j < 4; ++j) { const int c = lane * 8 + 512 * j; w[j] = *(const v4u*)(G + (size_t)row * DIN + c); s4[j] = *(const f32x4*)(SS + (size_t)row * 32 + 4 * (c >> 8)); }
    for (; row < T; row += NGW) {
        bf16* gr = G + (size_t)row * DIN;
        const int nrow = row + NGW; v4u wn[4]; f32x4 sn[4];
#pragma unroll
        for (int j = 0; j < 4; ++j) { const int c = lane * 8 + 512 * j;
            if (nrow < T) { wn[j] = *(const v4u*)(G + (size_t)nrow * DIN + c); sn[j] = *(const f32x4*)(SS + (size_t)nrow * 32 + 4 * (c >> 8)); } else { wn[j] = w[j]; sn[j] = s4[j]; } }
#pragma unroll
        for (int j = 0; j < 4; ++j) {
            const int c = lane * 8 + 512 * j;
            const float rstd = 1.0f / sqrtf(((s4[j][0] + s4[j][1]) + (s4[j][2] + s4[j][3])) * (1.0f / 256.f) + EPS);
            v4u o;
            o.x = pk2(bf_lo(w[j].x) * rstd, bf_hi(w[j].x) * rstd); o.y = pk2(bf_lo(w[j].y) * rstd, bf_hi(w[j].y) * rstd);
            o.z = pk2(bf_lo(w[j].z) * rstd, bf_hi(w[j].z) * rstd); o.w = pk2(bf_lo(w[j].w) * rstd, bf_hi(w[j].w) * rstd);
            *(v4u*)(gr + c) = o;
        }
#pragma unroll
        for (int j = 0; j < 4; ++j) { w[j] = wn[j]; s4[j] = sn[j]; }
    }
}

constexpr int LP = 136;
#define MFMA16(a, b, c) __builtin_amdgcn_mfma_f32_16x16x32_bf16((a), (b), (c), 0, 0, 0)
typedef short s16x4 __attribute__((ext_vector_type(4)));
__device__ __forceinline__ bf16x8 tr_frag(const LAS bf16* tile, int pitch, int k0, int c, int lane) {
    const int g = lane >> 4, q = (lane & 15) >> 2, p = lane & 3;
    const LAS bf16* a0 = tile + (k0 + 8 * g + q) * pitch + 16 * c + 4 * p;
    const s16x4 lo = __builtin_amdgcn_ds_read_tr16_b64_v4i16((LAS s16x4*)a0);
    const s16x4 hi = __builtin_amdgcn_ds_read_tr16_b64_v4i16((LAS s16x4*)(a0 + 4 * pitch));
    return __builtin_shufflevector(lo, hi, 0, 1, 2, 3, 4, 5, 6, 7);
}
__device__ __forceinline__ bf16x8 tr_frag_pair(const LAS bf16* tile, int pitch, int k0, int c2, int n, int lane) {
    const int g = lane >> 4, q = (lane & 15) >> 2, p = lane & 3;
    const LAS bf16* a0 = tile + (k0 + 8 * g + q) * pitch + 32 * c2 + 8 * p + 4 * n;
    const s16x4 lo = __builtin_amdgcn_ds_read_tr16_b64_v4i16((LAS s16x4*)a0);
    const s16x4 hi = __builtin_amdgcn_ds_read_tr16_b64_v4i16((LAS s16x4*)(a0 + 4 * pitch));
    return __builtin_shufflevector(lo, hi, 0, 1, 2, 3, 4, 5, 6, 7);
}
constexpr int VP = 272;
__device__ __forceinline__ void gate_prompt_unit(CArgs& a, ldsp lds, int unit, int tid) {
    const int g = unit & 7, bc = unit >> 3, c = bc & 15, b = bc >> 4, row0 = bc * 128;
    const int wid = tid >> 6, lane = tid & 63, fr = lane & 15, fq = lane >> 4, wr = wid >> 2, wc = wid & 3;
    const bf16* Z = (const bf16*)(a.ws + WS_BIG); bf16* G = (bf16*)(a.ws + WS_G); const float* stats = (const float*)(a.ws + WS_STATS);
    LAS bf16* WsA = (LAS bf16*)lds; LAS bf16* vT = (LAS bf16*)(lds + 128 * LP * 2);
    const int w0 = (tid & 31) * 8, sb = tid >> 5;
    v4u raw[8]; float mu[8], rs[8];
#pragma unroll
    for (int i = 0; i < 8; ++i) {
        const int row = row0 + sb + 16 * i;
        raw[i] = *(const v4u*)(Z + (size_t)row * 4096 + 2048 + g * 256 + w0);
        const float s1 = stats[2 * row], s2 = stats[2 * row + 1];
        mu[i] = s1 * (1.f / 2048.f); rs[i] = s2;
    }
    const float* lng = a.in[11] + g * 256 + w0; const float* lnb = a.in[12] + g * 256 + w0;
    const f32x4 g0 = *(const f32x4*)(lng), g1 = *(const f32x4*)(lng + 4), b0 = *(const f32x4*)(lnb), b1 = *(const f32x4*)(lnb + 4);
    const float* w_s = a.in[13] + (size_t)g * 16384;
    {
        const int t0 = tid >> 5, s0 = (tid & 31) * 4;
#pragma unroll
        for (int i = 0; i < 8; ++i) {
            const int t = t0 + 16 * i;
            const f32x4 v = *(const f32x4*)(w_s + t * 128 + s0);
            v2u w; w.x = pk2(s0 <= t ? v[0] : 0.f, s0 + 1 <= t ? v[1] : 0.f); w.y = pk2(s0 + 2 <= t ? v[2] : 0.f, s0 + 3 <= t ? v[3] : 0.f);
            *(LAS v2u*)(WsA + t * LP + s0) = w;
        }
    }
#pragma unroll
    for (int i = 0; i < 8; ++i) {
        const int s = sb + 16 * i;
        const float m = mu[i], var = rs[i] * (1.f / 2048.f) - m * m, rstd = 1.0f / sqrtf(var + EPS);
        f32x4 v0, v1;
        v0[0] = (bf_lo(raw[i].x) - m) * rstd * g0[0] + b0[0]; v0[1] = (bf_hi(raw[i].x) - m) * rstd * g0[1] + b0[1];
        v0[2] = (bf_lo(raw[i].y) - m) * rstd * g0[2] + b0[2]; v0[3] = (bf_hi(raw[i].y) - m) * rstd * g0[3] + b0[3];
        v1[0] = (bf_lo(raw[i].z) - m) * rstd * g1[0] + b1[0]; v1[1] = (bf_hi(raw[i].z) - m) * rstd * g1[1] + b1[1];
        v1[2] = (bf_lo(raw[i].w) - m) * rstd * g1[2] + b1[2]; v1[3] = (bf_hi(raw[i].w) - m) * rstd * g1[3] + b1[3];
        { v4u w; w.x = pk2(v0[0], v0[1]); w.y = pk2(v0[2], v0[3]); w.z = pk2(v1[0], v1[1]); w.w = pk2(v1[2], v1[3]); *(LAS v4u*)(vT + s * VP + w0) = w; }
        if (c == 15) { float* o = a.out + O_VP + ((size_t)(b * 128 + s)) * 2048 + g * 256 + w0; __builtin_nontemporal_store(v0, (f32x4*)o); __builtin_nontemporal_store(v1, (f32x4*)(o + 4)); }
    }
    v4u uu[4][2];
#pragma unroll
    for (int m = 0; m < 4; ++m)
#pragma unroll
        for (int c2 = 0; c2 < 2; ++c2) uu[m][c2] = *(const v4u*)(Z + (size_t)(row0 + wr * 64 + m * 16 + fr) * 4096 + g * 256 + wc * 64 + c2 * 32 + fq * 8);
    LDS_BARRIER();
    f32x4 acc[4][4];
#pragma unroll
    for (int m = 0; m < 4; ++m)
#pragma unroll
        for (int n = 0; n < 4; ++n) acc[m][n] = (f32x4){0.f, 0.f, 0.f, 0.f};
    const int kend = wr * 64 + 64;
    for (int k0 = 0; k0 < kend; k0 += 32) {
        bf16x8 af[4], bfr[4];
#pragma unroll
        for (int m = 0; m < 4; ++m) af[m] = *(const LAS bf16x8*)(WsA + (wr * 64 + m * 16 + fr) * LP + k0 + fq * 8);
#pragma unroll
        for (int n = 0; n < 4; ++n) bfr[n] = tr_frag_pair(vT, VP, k0, wc * 2 + (n >> 1), n & 1, lane);
#pragma unroll
        for (int m = 0; m < 4; ++m)
#pragma unroll
            for (int n = 0; n < 4; ++n) acc[m][n] = MFMA16(bfr[n], af[m], acc[m][n]);
    }
    const float* b_s = a.in[14] + g * 128;
#pragma unroll
    for (int m = 0; m < 4; ++m) {
        const int t = wr * 64 + m * 16 + fr, row = row0 + t; const float bs = b_s[t];
#pragma unroll
        for (int c2 = 0; c2 < 2; ++c2) {
            const int col = g * 256 + wc * 64 + c2 * 32 + fq * 8;
            const v4u u = uu[m][c2]; const f32x4 a0 = acc[m][2 * c2], a1 = acc[m][2 * c2 + 1];
            v4u o;
            o.x = pk2(bf_lo(u.x) * (a0[0] + bs), bf_hi(u.x) * (a0[1] + bs)); o.y = pk2(bf_lo(u.y) * (a0[2] + bs), bf_hi(u.y) * (a0[3] + bs));
            o.z = pk2(bf_lo(u.z) * (a1[0] + bs), bf_hi(u.z) * (a1[1] + bs)); o.w = pk2(bf_lo(u.w) * (a1[2] + bs), bf_hi(u.w) * (a1[3] + bs));
            *(v4u*)(G + (size_t)row * DGM + col) = o;
        }
    }
    LDS_BARRIER();
}
__device__ __forceinline__ void gate_sample_unit(CArgs& a, int bsq, int tid) {
    const bf16* Z = (const bf16*)(a.ws + WS_BIG); bf16* G = (bf16*)(a.ws + WS_G); const float* stats = (const float*)(a.ws + WS_STATS);
    const int col = tid * 4, g = col >> 8, row0 = TP + bsq * 8;
    const f32x4 lg = *(const f32x4*)(a.in[11] + col), lb = *(const f32x4*)(a.in[12] + col);
    v2u raw[8], uu[8]; float s1[8], s2[8];
#pragma unroll
    for (int t = 0; t < 8; ++t) {
        const int row = row0 + t;
        raw[t] = *(const v2u*)(Z + (size_t)row * 4096 + 2048 + col); uu[t] = *(const v2u*)(Z + (size_t)row * 4096 + col);
        s1[t] = stats[2 * row]; s2[t] = stats[2 * row + 1];
    }
    f32x4 v[8];
#pragma unroll
    for (int t = 0; t < 8; ++t) {
        const float mu = s1[t] * (1.f / 2048.f), var = s2[t] * (1.f / 2048.f) - mu * mu, rstd = 1.0f / sqrtf(var + EPS);
        v[t][0] = (bf_lo(raw[t].x) - mu) * rstd * lg[0] + lb[0]; v[t][1] = (bf_hi(raw[t].x) - mu) * rstd * lg[1] + lb[1];
        v[t][2] = (bf_lo(raw[t].y) - mu) * rstd * lg[2] + lb[2]; v[t][3] = (bf_hi(raw[t].y) - mu) * rstd * lg[3] + lb[3];
        __builtin_nontemporal_store(v[t], (f32x4*)(a.out + O_VS + (size_t)(bsq * 8 + t) * 2048 + col));
    }
    const float* w_s = a.in[13] + (size_t)g * 16384; const float* b_s = a.in[14] + g * 128;
#pragma unroll
    for (int t = 0; t < 8; ++t) {
        const int row = row0 + t; const float bs = b_s[t];
        f32x4 s = (f32x4){bs, bs, bs, bs};
#pragma unroll
        for (int q = 0; q < 8; ++q) if (q <= t) s += w_s[t * 128 + q] * v[q];
        const v2u u = uu[t];
        v2u o; o.x = pk2(bf_lo(u.x) * s[0], bf_hi(u.x) * s[1]); o.y = pk2(bf_lo(u.y) * s[2], bf_hi(u.y) * s[3]);
        *(v2u*)(G + (size_t)row * DGM + col) = o;
    }
}

constexpr int TPI = 144, XPI = 72;
constexpr int L_CM = 0, L_BM = 36864, L_BWT = 73728, L_XST = 110592, L_STB = 129024, L_ACUM = 146432, L_DTS = 146944, L_WS = 147456, L_EAC = 147968, L_CWP = 148480;
__device__ __forceinline__ void cv8(const v4u w, float (&r)[8]) {
    r[0] = bf_lo(w.x); r[1] = bf_hi(w.x); r[2] = bf_lo(w.y); r[3] = bf_hi(w.y); r[4] = bf_lo(w.z); r[5] = bf_hi(w.z); r[6] = bf_lo(w.w); r[7] = bf_hi(w.w);
}
__device__ __forceinline__ void ssd_prompt_unit(CArgs& a, ldsp lds, int b, int h, int tid) {
    const int g = h >> 2, wid = tid >> 6, lane = tid & 63, fr = lane & 15, fq = lane >> 4, wr = wid >> 2, wc = wid & 3;
    const bf16* ZX = (const bf16*)(a.ws + WS_BIG); bf16* G = (bf16*)(a.ws + WS_G); const float* DT = (const float*)(a.ws + WS_DT); float* SS = (float*)(a.ws + WS_SS);
    LAS bf16* CM = (LAS bf16*)(lds + L_CM); LAS bf16* BM = (LAS bf16*)(lds + L_BM); LAS bf16* BWT = (LAS bf16*)(lds + L_BWT);
    LAS bf16* XST = (LAS bf16*)(lds + L_XST); LAS bf16* STB = (LAS bf16*)(lds + L_STB);
    LAS float* ACUM = (LAS float*)(lds + L_ACUM); LAS float* DTS = (LAS float*)(lds + L_DTS); LAS float* WSV = (LAS float*)(lds + L_WS); LAS float* EAC = (LAS float*)(lds + L_EAC);
    const float A_h = -expf(a.in[20][h]), D_h = a.in[21][h], dtb = a.in[19][h];
    f32x4 st[4];
#pragma unroll
    for (int m = 0; m < 4; ++m) st[m] = (f32x4){0.f, 0.f, 0.f, 0.f};
    const int ck = tid % 40, tg = tid / 40, tb = tg * 11;
    int seg, ch0, cl;
    if (ck < 8) { seg = 0; cl = ck * 8; ch0 = h * 64 + cl; } else if (ck < 24) { seg = 1; cl = (ck - 8) * 8; ch0 = 2048 + g * 128 + cl; } else { seg = 2; cl = (ck - 24) * 8; ch0 = 3072 + g * 128 + cl; }
    LAS float* CWP = (LAS float*)(lds + L_CWP);
    {
        const float* conv_w = a.in[17]; const float* conv_b = a.in[18];
        for (int i = tid; i < 5 * 320; i += NTHR) { const int k = i / 320, cc = i % 320, ch = cc < 64 ? h * 64 + cc : (cc < 192 ? 2048 + g * 128 + (cc - 64) : 3072 + g * 128 + (cc - 192)); CWP[i] = k < 4 ? conv_w[k * 4096 + ch] : conv_b[ch]; }
    }
    const int ccl = (seg == 0 ? 0 : (seg == 1 ? 64 : 192)) + cl;
    v4u pf[14]; float dpf0 = 0.f, dpf1 = 0.f;
#define SSD_ISSUE(cn) do { const bf16* zp_ = ZX + (size_t)(b * 2048 + (cn) * 128) * ZXP + 2048 + ch0; \
        _Pragma("unroll") for (int i_ = 0; i_ < 14; ++i_) { const int rel_ = tb + i_ - 3; \
            if (rel_ < 128 && ((cn) > 0 || rel_ >= 0)) pf[i_] = *(const v4u*)(zp_ + (long)rel_ * ZXP); else pf[i_] = (v4u){0u, 0u, 0u, 0u}; } \
        } while (0)
#define SSD_DT(cn) do { if (wid == 0) { const float* dp_ = DT + (size_t)(b * 2048 + (cn) * 128 + 2 * lane) * 32 + h; dpf0 = dp_[0]; dpf1 = dp_[32]; } } while (0)
    SSD_DT(0);
    for (int c = 0; c < 16; ++c) {
        const int row0 = b * 2048 + c * 128;
        SSD_ISSUE(c);
        const float dr0 = dpf0, dr1 = dpf1;
        if (c < 15) SSD_DT(c + 1);
        const int trow = wid * 16 + fr;
        if (wid == 0) {
            const int t0 = 2 * lane;
            const float d0 = softplus_f(dr0 + dtb), d1 = softplus_f(dr1 + dtb);
            const float a0 = d0 * A_h, a1 = d1 * A_h, pr = a0 + a1; float inc = pr;
#pragma unroll
            for (int o = 1; o < 64; o <<= 1) { const float n = __shfl_up(inc, o); if (lane >= o) inc += n; }
            const float exc = inc - pr;
            ACUM[t0] = exc + a0; ACUM[t0 + 1] = inc; DTS[t0] = d0; DTS[t0 + 1] = d1;
        }
#pragma unroll
        for (int m = 0; m < 4; ++m) { v2u w; w.x = pk2(st[m][0], st[m][1]); w.y = pk2(st[m][2], st[m][3]); *(LAS v2u*)(STB + (m * 16 + fr) * LP + wid * 16 + fq * 4) = w; }
        LDS_BARRIER();
        const float aend = ACUM[127];
        {
            f32x2 cw0[4], cw1[4], cw2[4], cw3[4], cb[4];
#pragma unroll
            for (int j = 0; j < 4; ++j) { cw0[j] = *(const LAS f32x2*)(CWP + ccl + 2 * j); cw1[j] = *(const LAS f32x2*)(CWP + 320 + ccl + 2 * j); cw2[j] = *(const LAS f32x2*)(CWP + 640 + ccl + 2 * j);
                                          cw3[j] = *(const LAS f32x2*)(CWP + 960 + ccl + 2 * j); cb[j] = *(const LAS f32x2*)(CWP + 1280 + ccl + 2 * j); }
            LAS bf16* rbase = seg == 0 ? XST + tb * XPI + cl : (seg == 1 ? BM : CM) + tb * TPI + cl;
            LAS bf16* r2base = BWT + tb * TPI + cl;
            LAS float* wbase = DTS + tb; LAS float* abase = ACUM + tb;
            int nval = 128 - tb;
            asm volatile("" : "+v"(rbase), "+v"(r2base), "+v"(wbase), "+v"(abase), "+v"(nval));
            f32x2 rr[4][4];
#define CVP(W_, R_) do { R_[0] = (f32x2){bf_lo(W_.x), bf_hi(W_.x)}; R_[1] = (f32x2){bf_lo(W_.y), bf_hi(W_.y)}; R_[2] = (f32x2){bf_lo(W_.z), bf_hi(W_.z)}; R_[3] = (f32x2){bf_lo(W_.w), bf_hi(W_.w)}; } while (0)
            CVP(pf[0], rr[0]); CVP(pf[1], rr[1]); CVP(pf[2], rr[2]);
#pragma unroll
            for (int i = 0; i < 11; ++i) {
                CVP(pf[i + 3], rr[(i + 3) & 3]);
                if (i < nval) {
                    f32x2 v[4], x[4], e[4];
#pragma unroll
                    for (int j = 0; j < 4; ++j) x[j] = cb[j] + cw0[j] * rr[i & 3][j];
#pragma unroll
                    for (int j = 0; j < 4; ++j) x[j] = x[j] + cw1[j] * rr[(i + 1) & 3][j];
#pragma unroll
                    for (int j = 0; j < 4; ++j) x[j] = x[j] + cw2[j] * rr[(i + 2) & 3][j];
#pragma unroll
                    for (int j = 0; j < 4; ++j) x[j] = x[j] + cw3[j] * rr[(i + 3) & 3][j];
#pragma unroll
                    for (int j = 0; j < 4; ++j) e[j] = x[j] * (-1.4426950409f);
#pragma unroll
                    for (int j = 0; j < 4; ++j) { e[j].x = __builtin_amdgcn_exp2f(e[j].x); e[j].y = __builtin_amdgcn_exp2f(e[j].y); }
#pragma unroll
                    for (int j = 0; j < 4; ++j) e[j] = e[j] + 1.0f;
#pragma unroll
                    for (int j = 0; j < 4; ++j) { e[j].x = __builtin_amdgcn_rcpf(e[j].x); e[j].y = __builtin_amdgcn_rcpf(e[j].y); }
#pragma unroll
                    for (int j = 0; j < 4; ++j) v[j] = x[j] * e[j];
                    v4u w; w.x = pk2(v[0].x, v[0].y); w.y = pk2(v[1].x, v[1].y); w.z = pk2(v[2].x, v[2].y); w.w = pk2(v[3].x, v[3].y);
                    if (seg == 0) *(LAS v4u*)(rbase + i * XPI) = w;
                    else {
                        *(LAS v4u*)(rbase + i * TPI) = w;
                        if (seg == 1) {
                            const float wsv = wbase[i] * exp_f(aend - abase[i]);
                            const f32x2 a0 = v[0] * wsv, a1 = v[1] * wsv, a2 = v[2] * wsv, a3 = v[3] * wsv;
                            v4u w2; w2.x = pk2(a0.x, a0.y); w2.y = pk2(a1.x, a1.y); w2.z = pk2(a2.x, a2.y); w2.w = pk2(a3.x, a3.y);
                            *(LAS v4u*)(r2base + i * TPI) = w2;
                        }
                    }
                }
                __builtin_amdgcn_sched_barrier(0);
            }
#undef CVP
        }
        v2u zz[4];
#pragma unroll
        for (int n = 0; n < 4; ++n) zz[n] = *(const v2u*)(ZX + (size_t)(row0 + trow) * ZXP + h * 64 + n * 16 + fq * 4);
        unsigned pd0, pd1;
        {
            const int nrow0 = (c < 15 ? row0 + 128 : row0);
            const int li0 = tid, li1 = tid < 256 ? tid + 512 : tid;
            const int ra = li0 / 6, ka = li0 % 6, rb = li1 / 6, kb = li1 % 6;
            const int oa = ka == 0 ? h * 64 : (ka == 1 ? 2048 + h * 64 : (ka < 4 ? 4096 + g * 128 + (ka - 2) * 64 : 5120 + g * 128 + (ka - 4) * 64));
            const int ob = kb == 0 ? h * 64 : (kb == 1 ? 2048 + h * 64 : (kb < 4 ? 4096 + g * 128 + (kb - 2) * 64 : 5120 + g * 128 + (kb - 4) * 64));
            const bf16* pa = ZX + (size_t)(nrow0 + ra) * ZXP + oa; const bf16* pb = ZX + (size_t)(nrow0 + rb) * ZXP + ob;
            pd0 = *(const unsigned*)pa;
            pd1 = *(const unsigned*)pb;
        }
        LDS_BARRIER();
        {
            f32x4 cbv[4][2];
#pragma unroll
            for (int m = 0; m < 4; ++m)
#pragma unroll
                for (int n = 0; n < 2; ++n) cbv[m][n] = (f32x4){0.f, 0.f, 0.f, 0.f};
#pragma unroll
            for (int k0 = 0; k0 < 128; k0 += 32) {
                bf16x8 af[4], bfr[2];
#pragma unroll
                for (int m = 0; m < 4; ++m) af[m] = *(const LAS bf16x8*)(CM + (wr * 64 + m * 16 + fr) * TPI + k0 + fq * 8);
#pragma unroll
                for (int n = 0; n < 2; ++n) bfr[n] = *(const LAS bf16x8*)(BM + (wc * 32 + n * 16 + fr) * TPI + k0 + fq * 8);
#pragma unroll
                for (int m = 0; m < 4; ++m)
#pragma unroll
                    for (int n = 0; n < 2; ++n) cbv[m][n] = MFMA16(bfr[n], af[m], cbv[m][n]);
            }
            LDS_BARRIER();
#pragma unroll
            for (int m = 0; m < 4; ++m) {
                const int t = wr * 64 + m * 16 + fr; const float at = ACUM[t];
#pragma unroll
                for (int n = 0; n < 2; ++n) {
                    const int s0 = wc * 32 + n * 16 + fq * 4;
                    v2u w; w.x = 0u; w.y = 0u;
                    if (wc * 2 + n <= wr * 4 + m) {
                        float mv[4];
#pragma unroll
                        for (int j = 0; j < 4; ++j) { const int s = s0 + j; mv[j] = (s <= t) ? cbv[m][n][j] * exp_f(at - ACUM[s]) * DTS[s] : 0.f; }
                        w.x = pk2(mv[0], mv[1]); w.y = pk2(mv[2], mv[3]);
                    }
                    *(LAS v2u*)(BM + t * TPI + s0) = w;
                }
            }
            LDS_BARRIER();
        }
        {
            f32x4 yd[4], yo[4];
#pragma unroll
            for (int n = 0; n < 4; ++n) { yd[n] = (f32x4){0.f, 0.f, 0.f, 0.f}; yo[n] = (f32x4){0.f, 0.f, 0.f, 0.f}; }
#pragma unroll
            for (int k0 = 0; k0 < 128; k0 += 32) {
                if (k0 <= wid * 16 + 15) {
                    const bf16x8 am = *(const LAS bf16x8*)(BM + trow * TPI + k0 + fq * 8);
#pragma unroll
                    for (int n = 0; n < 4; ++n) { const bf16x8 bx = tr_frag(XST, XPI, k0, n, lane); yd[n] = MFMA16(bx, am, yd[n]); }
                }
                const bf16x8 ac = *(const LAS bf16x8*)(CM + trow * TPI + k0 + fq * 8);
#pragma unroll
                for (int n = 0; n < 4; ++n) { const bf16x8 bs = *(const LAS bf16x8*)(STB + (n * 16 + fr) * LP + k0 + fq * 8); yo[n] = MFMA16(bs, ac, yo[n]); }
            }
            const int row = row0 + trow; const float ea = exp_f(ACUM[trow]);
            float ssq = 0.f;
#pragma unroll
            for (int n = 0; n < 4; ++n) {
                const int p0 = n * 16 + fq * 4;
                const v2u xv = *(const LAS v2u*)(XST + trow * XPI + p0);
                const f32x2 z01 = (f32x2){bf_lo(zz[n].x), bf_hi(zz[n].x)}, z23 = (f32x2){bf_lo(zz[n].y), bf_hi(zz[n].y)};
                f32x2 y01 = (f32x2){yo[n][0], yo[n][1]} * ea, y23 = (f32x2){yo[n][2], yo[n][3]} * ea;
                f32x2 e01 = z01 * (-1.4426950409f), e23 = z23 * (-1.4426950409f);
                y01 = y01 + (f32x2){yd[n][0], yd[n][1]}; y23 = y23 + (f32x2){yd[n][2], yd[n][3]};
                e01.x = __builtin_amdgcn_exp2f(e01.x); e01.y = __builtin_amdgcn_exp2f(e01.y); e23.x = __builtin_amdgcn_exp2f(e23.x); e23.y = __builtin_amdgcn_exp2f(e23.y);
                y01 = y01 + (f32x2){bf_lo(xv.x), bf_hi(xv.x)} * D_h; y23 = y23 + (f32x2){bf_lo(xv.y), bf_hi(xv.y)} * D_h;
                e01 = e01 + 1.0f; e23 = e23 + 1.0f;
                e01.x = __builtin_amdgcn_rcpf(e01.x); e01.y = __builtin_amdgcn_rcpf(e01.y); e23.x = __builtin_amdgcn_rcpf(e23.x); e23.y = __builtin_amdgcn_rcpf(e23.y);
                e01 = e01 * z01; e23 = e23 * z23;
                y01 = y01 * e01; y23 = y23 * e23;
                const f32x2 q2 = y01 * y01 + y23 * y23;
                ssq += q2.x + q2.y;
                v2u w; w.x = pk2(y01.x, y01.y); w.y = pk2(y23.x, y23.y);
                *(v2u*)(G + (size_t)row * DIN + h * 64 + p0) = w;
            }
            ssq += __shfl_xor(ssq, 16); ssq += __shfl_xor(ssq, 32);
            if (fq == 0) SS[(size_t)row * 32 + h] = ssq;
        }
        {
            const float dec = exp_f(aend);
#pragma unroll
            for (int m = 0; m < 4; ++m) st[m] = st[m] * dec;
#pragma unroll
            for (int k0 = 0; k0 < 128; k0 += 32) {
                const bf16x8 bw = tr_frag(BWT, TPI, k0, wid, lane);
#pragma unroll
                for (int m = 0; m < 4; ++m) { const bf16x8 ax = tr_frag(XST, XPI, k0, m, lane); st[m] = MFMA16(bw, ax, st[m]); }
            }
        }
        asm volatile("" :: "v"(pd0), "v"(pd1));
        LDS_BARRIER();
    }
#undef SSD_ISSUE
#undef SSD_DT
    if (tid < 120) {
        const int r = tid / 40;
        float v[8]; cv8(*(const v4u*)(ZX + (size_t)(b * 2048 + 2045 + r) * ZXP + 2048 + ch0), v);
        float* o = a.out + O_CP + (size_t)(b * 3 + r) * 4096 + ch0;
        *(f32x4*)o = (f32x4){v[0], v[1], v[2], v[3]}; *(f32x4*)(o + 4) = (f32x4){v[4], v[5], v[6], v[7]};
    }
    float* so = a.out + O_SP + (size_t)(b * 32 + h) * 8192;
#pragma unroll
    for (int m = 0; m < 4; ++m) __builtin_nontemporal_store(st[m], (f32x4*)(so + (m * 16 + fr) * 128 + wid * 16 + fq * 4));
}

constexpr int S_RAW = 0, S_XS = 14080, S_BM = 16128, S_CM = 20224, S_DT = 24320, S_MM = 24416, S_YS = 24672, S_SLOT = 26752, S_CW = 2 * S_SLOT;
__device__ __forceinline__ int ssd_chan(int cc, int h, int g) { return cc < 64 ? h * 64 + cc : (cc < 192 ? 2048 + g * 128 + (cc - 64) : 3072 + g * 128 + (cc - 192)); }
__device__ __forceinline__ void ssd_sample_units(CArgs& a, ldsp lds, int bid, int G_, int tid) {
    const int lane = tid & 63, wid = tid >> 6;
    const bf16* ZX = (const bf16*)(a.ws + WS_BIG); bf16* G = (bf16*)(a.ws + WS_G); const float* DT = (const float*)(a.ws + WS_DT); float* SS = (float*)(a.ws + WS_SS);
    LAS float* CW = (LAS float*)(lds + S_CW);
    const float* sconv = a.in[5];
    const int p = tid >> 3, q = tid & 7, n0 = q * 16;
    int hc = -1;
    float A_h = 0.f, D_h = 0.f, dtb = 0.f;
    f32x4 s0[2][4]; float cv0[2] = {0.f, 0.f}, cv1[2] = {0.f, 0.f}; unsigned short zb[2][7] = {{0, 0, 0, 0, 0, 0, 0}, {0, 0, 0, 0, 0, 0, 0}}; float dtv[2] = {0.f, 0.f}; unsigned short zvb[2] = {0, 0};
#define SMP_ISSUE(j_, u_) do { const int bs_ = (u_) >> 5, h_ = (u_) & 31, g_ = h_ >> 2, r0_ = TP + bs_ * 8; \
        const float* sp_ = a.in[4] + ((size_t)(bs_ * 32 + h_) * 64 + p) * 128 + n0; \
        _Pragma("unroll") for (int i_ = 0; i_ < 4; ++i_) s0[j_][i_] = *(const f32x4*)(sp_ + 4 * i_); \
        { const int e_ = tid; cv0[j_] = sconv[(size_t)(bs_ * 3 + e_ / 320) * 4096 + ssd_chan(e_ % 320, h_, g_)]; } \
        { const int e_ = tid + NTHR, rr_ = e_ / 320, ch_ = ssd_chan(e_ % 320, h_, g_); \
          if (e_ < 960) cv1[j_] = sconv[(size_t)(bs_ * 3 + rr_) * 4096 + ch_]; else zb[j_][1] = ZX[(size_t)(r0_ + rr_ - 3) * ZXP + 2048 + ch_]; } \
        _Pragma("unroll") for (int i_ = 2; i_ < 7; ++i_) { const int e_ = tid + i_ * NTHR; \
            if (e_ < 11 * 320) zb[j_][i_] = ZX[(size_t)(r0_ + e_ / 320 - 3) * ZXP + 2048 + ssd_chan(e_ % 320, h_, g_)]; } \
        if (tid < 8) dtv[j_] = DT[(size_t)(r0_ + tid) * 32 + h_]; \
        zvb[j_] = ZX[(size_t)(r0_ + q) * ZXP + h_ * 64 + p]; } while (0)
    int u = bid;
    if (u < 4096) { SMP_ISSUE(0, u); if (u + G_ < 4096) SMP_ISSUE(1, u + G_); }
    for (; u < 4096; u += 2 * G_) {
        const int nu = (u + G_ < 4096) ? 2 : 1;
        const int h = u & 31, g = h >> 2;
        const int h1 = (u + G_) & 31;
        if (h != hc || (nu == 2 && h1 != h)) {
            LDS_BARRIER();
            A_h = -expf(a.in[20][h]); D_h = a.in[21][h]; dtb = a.in[19][h];
            const float* conv_w = a.in[17]; const float* conv_b = a.in[18];
            for (int i = tid; i < 5 * 320; i += NTHR) { const int k = i / 320, cc = i % 320, ch = ssd_chan(cc, h, g); CW[i] = k < 4 ? conv_w[k * 4096 + ch] : conv_b[ch]; }
            hc = h;
        }
        float rv[2][7]; f32x4 sc[2][4]; float zc[2];
#pragma unroll
        for (int j = 0; j < 2; ++j) {
            LAS float* RAW = (LAS float*)(lds + j * S_SLOT + S_RAW); LAS float* DTs = (LAS float*)(lds + j * S_SLOT + S_DT);
#pragma unroll
            for (int i = 0; i < 7; ++i) { const int e = tid + i * NTHR; rv[j][i] = i == 0 ? cv0[j] : (i == 1 && e < 960 ? cv1[j] : bf1(zb[j][i])); }
#pragma unroll
            for (int i = 0; i < 7; ++i) { const int e = tid + i * NTHR; if (e < 11 * 320) RAW[e] = rv[j][i]; }
            if (tid < 8) DTs[tid] = softplus_f(dtv[j] + dtb);
#pragma unroll
            for (int i = 0; i < 4; ++i) sc[j][i] = s0[j][i];
            zc[j] = bf1(zvb[j]);
        }
        LDS_BARRIER();
        if (u + 2 * G_ < 4096) { SMP_ISSUE(0, u + 2 * G_); if (u + 3 * G_ < 4096) SMP_ISSUE(1, u + 3 * G_); }
        float dts[2][8], acs[2][8];
#pragma unroll
        for (int j = 0; j < 2; ++j) {
            LAS float* DTs = (LAS float*)(lds + j * S_SLOT + S_DT);
            float ac = 0.f;
#pragma unroll
            for (int t = 0; t < 8; ++t) { dts[j][t] = DTs[t]; ac += dts[j][t] * A_h; acs[j][t] = ac; }
        }
#pragma unroll
        for (int j = 0; j < 2; ++j) {
            LAS float* RAW = (LAS float*)(lds + j * S_SLOT + S_RAW); LAS float* XS = (LAS float*)(lds + j * S_SLOT + S_XS); LAS float* BMs = (LAS float*)(lds + j * S_SLOT + S_BM); LAS float* CMs = (LAS float*)(lds + j * S_SLOT + S_CM);
#pragma unroll
            for (int i = 0; i < 5; ++i) {
                const int e = tid + i * NTHR, t = e / 320, cc = e % 320;
                float v = CW[4 * 320 + cc];
#pragma unroll
                for (int k = 0; k < 4; ++k) v += RAW[(t + k) * 320 + cc] * CW[k * 320 + cc];
                v = silu_f(v);
                if (cc < 64) XS[t * 64 + cc] = v; else if (cc < 192) BMs[t * 128 + cc - 64] = v; else CMs[t * 128 + cc - 192] = v;
            }
        }
        LDS_BARRIER();
#pragma unroll
        for (int j = 0; j < 2; ++j) if (j < nu) {
            const int uu = u + j * G_, bsq = uu >> 5;
            LAS float* XS = (LAS float*)(lds + j * S_SLOT + S_XS); LAS float* BMs = (LAS float*)(lds + j * S_SLOT + S_BM); LAS float* CMs = (LAS float*)(lds + j * S_SLOT + S_CM); LAS float* MM = (LAS float*)(lds + j * S_SLOT + S_MM);
            const float aend = acs[j][7];
#pragma unroll
            for (int i = 5; i < 7; ++i) { const int e = tid + i * NTHR; if (e >= 8 * 320 && e < 11 * 320) a.out[O_CSS + (size_t)(bsq * 3 + e / 320 - 8) * 4096 + ssd_chan(e % 320, h, g)] = rv[j][i]; }
            {
                const float dec = exp_f(aend);
                f32x4 ns[4];
#pragma unroll
                for (int i = 0; i < 4; ++i) ns[i] = sc[j][i] * dec;
#pragma unroll
                for (int s = 0; s < 8; ++s) {
                    const float xw = XS[s * 64 + p] * dts[j][s] * exp_f(aend - acs[j][s]);
#pragma unroll
                    for (int i = 0; i < 4; ++i) { const f32x4 bv = *(const LAS f32x4*)(BMs + s * 128 + n0 + 4 * i); ns[i] += xw * bv; }
                }
                float* so = a.out + O_SSS + ((size_t)(bsq * 32 + h) * 64 + p) * 128 + n0;
#pragma unroll
                for (int i = 0; i < 4; ++i) __builtin_nontemporal_store(ns[i], (f32x4*)(so + 4 * i));
            }
            {
                const int pr = tid >> 3, t = pr >> 3, s = pr & 7;
                float cbv = 0.f;
#pragma unroll
                for (int i = 0; i < 4; ++i) { const f32x4 cv = *(const LAS f32x4*)(CMs + t * 128 + n0 + 4 * i), bv = *(const LAS f32x4*)(BMs + s * 128 + n0 + 4 * i); cbv += (cv[0] * bv[0] + cv[1] * bv[1]) + (cv[2] * bv[2] + cv[3] * bv[3]); }
                cbv += __shfl_xor(cbv, 1); cbv += __shfl_xor(cbv, 2); cbv += __shfl_xor(cbv, 4);
                float at = 0.f, as = 0.f, ds = 0.f;
#pragma unroll
                for (int k = 0; k < 8; ++k) { at = (t == k) ? acs[j][k] : at; as = (s == k) ? acs[j][k] : as; ds = (s == k) ? dts[j][k] : ds; }
                if (q == 0) MM[pr] = (s <= t) ? cbv * exp_f(at - as) * ds : 0.f;
            }
        }
        LDS_BARRIER();
#pragma unroll
        for (int j = 0; j < 2; ++j) if (j < nu) {
            LAS float* XS = (LAS float*)(lds + j * S_SLOT + S_XS); LAS float* CMs = (LAS float*)(lds + j * S_SLOT + S_CM); LAS float* MM = (LAS float*)(lds + j * S_SLOT + S_MM); LAS float* YS = (LAS float*)(lds + j * S_SLOT + S_YS);
            float mine = 0.f;
#pragma unroll
            for (int t = 0; t < 8; ++t) {
                float pt = 0.f;
#pragma unroll
                for (int i = 0; i < 4; ++i) { const f32x4 cv = *(const LAS f32x4*)(CMs + t * 128 + n0 + 4 * i); pt += (cv[0] * sc[j][i][0] + cv[1] * sc[j][i][1]) + (cv[2] * sc[j][i][2] + cv[3] * sc[j][i][3]); }
                pt += __shfl_xor(pt, 1); pt += __shfl_xor(pt, 2); pt += __shfl_xor(pt, 4);
                mine = (q == t) ? pt : mine;
            }
            float aq = 0.f;
#pragma unroll
            for (int k = 0; k < 8; ++k) aq = (q == k) ? acs[j][k] : aq;
            float y = exp_f(aq) * mine + D_h * XS[q * 64 + p];
#pragma unroll
            for (int s = 0; s < 8; ++s) y += MM[q * 8 + s] * XS[s * 64 + p];
            YS[q * 64 + p] = y * silu_f(zc[j]);
        }
        LDS_BARRIER();
#pragma unroll
        for (int j = 0; j < 2; ++j) if (j < nu) {
            const int uu = u + j * G_, row0 = TP + (uu >> 5) * 8;
            LAS float* YS = (LAS float*)(lds + j * S_SLOT + S_YS);
            const int t = wid; const float y = YS[t * 64 + lane];
            G[(size_t)(row0 + t) * DIN + h * 64 + lane] = (bf16)f2bf(y);
            const float ssq = wave_sum(y * y);
            if (lane == 0) SS[(size_t)(row0 + t) * 32 + h] = ssq;
        }
    }
#undef SMP_ISSUE
    LDS_BARRIER();
}
#define XB_TMO      128
#define XB_XCNT(j)  (256  + 64 * (j))
#define XB_XSUB(j)  (1280 + 64 * (j))
#define XB_XGEN(j)  (2304 + 64 * (j))
#define XB_TOP      3328
#define XB_TOPGEN   3392
#define XCD_BAR_WORDS 3456
#define XB_SPIN_CAP (1u << 18)

__device__ __forceinline__ unsigned xb_ld(unsigned* p)              { return __hip_atomic_load(p, __ATOMIC_RELAXED, __HIP_MEMORY_SCOPE_AGENT); }
__device__ __forceinline__ unsigned xb_add(unsigned* p, unsigned v) { return __hip_atomic_fetch_add(p, v, __ATOMIC_RELAXED, __HIP_MEMORY_SCOPE_AGENT); }
__device__ __forceinline__ unsigned xb_xcc_id() { return (unsigned)__builtin_amdgcn_s_getreg((3 << 11) | 20) & 0xFu; }
#define XB_SPIN(cond, bar) do { unsigned _sp = 0; while (cond) { __builtin_amdgcn_s_sleep(1); \
    if ((++_sp & 255u) == 0u) { if (xb_ld(&(bar)[XB_TMO])) break; if (_sp > XB_SPIN_CAP) { atomicAdd(&(bar)[XB_TMO], 1u); break; } } } } while (0)

struct XcdBarrier {
    unsigned* bar; unsigned x;
    volatile LAS unsigned* st;
};

__device__ __forceinline__ XcdBarrier xcd_barrier_post(unsigned* bar, volatile LAS unsigned* st) {
    XcdBarrier b; b.bar = bar; b.x = xb_xcc_id(); b.st = st;
    if (threadIdx.x == 0) (void)xb_add(&bar[XB_XCNT(b.x)], 1u);
    return b;
}
__device__ __forceinline__ void xcd_barrier_complete(unsigned* bar, unsigned x, unsigned& nloc, unsigned& nx) {
    const unsigned G = gridDim.x * gridDim.y * gridDim.z;
    unsigned sum, cnt, mine, sp = 0u;
    for (;;) {
        sum = 0u; cnt = 0u; mine = 0u;
#pragma unroll
        for (unsigned j = 0; j < 16; ++j) { const unsigned c = xb_ld(&bar[XB_XCNT(j)]); sum += c; cnt += (c > 0u) ? 1u : 0u; mine = (j == x) ? c : mine; }
        if (sum == G) break;
        __builtin_amdgcn_s_sleep(1);
        if ((++sp & 255u) == 0u) { if (xb_ld(&bar[XB_TMO])) break; if (sp > XB_SPIN_CAP) { atomicAdd(&bar[XB_TMO], 1u); break; } }
    }
    nloc = mine > 0u ? mine : 1u; nx = cnt > 0u ? cnt : 1u;
}

__device__ __forceinline__ void xcd_barrier(const XcdBarrier& b) {
    asm volatile("s_waitcnt vmcnt(0)" ::: "memory");
    __syncthreads();
    if (threadIdx.x == 0) {
        unsigned* bar = b.bar;
        __builtin_amdgcn_s_waitcnt(0);
        unsigned nloc = b.st[0], nx = b.st[1];
        if (nloc == 0u) { xcd_barrier_complete(bar, b.x, nloc, nx); b.st[0] = nloc; b.st[1] = nx; }
        const unsigned old = xb_add(&bar[XB_XSUB(b.x)], 1u);
        const unsigned gen = old / nloc;
        if (old + 1u == (gen + 1u) * nloc) {
            __builtin_amdgcn_fence(__ATOMIC_RELEASE, "agent");
            asm volatile("s_waitcnt vmcnt(0)" ::: "memory");
            const unsigned og = xb_add(&bar[XB_TOP], 1u);
            const unsigned tg = og / nx;
            if (og + 1u == (tg + 1u) * nx) xb_add(&bar[XB_TOPGEN], 1u);
            else XB_SPIN(xb_ld(&bar[XB_TOPGEN]) == tg, bar);
            __builtin_amdgcn_fence(__ATOMIC_ACQUIRE, "agent");
            xb_add(&bar[XB_XGEN(b.x)], 1u);
            asm volatile("s_waitcnt vmcnt(0)" ::: "memory");
        } else {
            XB_SPIN(xb_ld(&bar[XB_XGEN(b.x)]) == gen, bar);
            __builtin_amdgcn_fence(__ATOMIC_ACQUIRE, "agent");
            asm volatile("s_waitcnt vmcnt(0)" ::: "memory");
        }
    }
    __syncthreads();
}

#ifndef PROBE
#define PROBE -1
#endif
#if PROBE == 12
#define PROBE12_EXTRA { int tid3 = threadIdx.x; asm volatile("" : "+v"(tid3)); ssd_sample_units(a, lds, bid, G_, tid3); }
#else
#define PROBE12_EXTRA
#endif
constexpr int NPH = 18;
__global__ void __launch_bounds__(NTHR, 2) mk_fwd(Args a_) {
    extern __shared__ __attribute__((aligned(16))) unsigned char lds_raw[];
    cg::grid_group grid = cg::this_grid();
    ldsp lds = (ldsp)lds_raw;
    const int ph_lo = a_.ph_lo, ph_hi = a_.ph_hi;
    volatile LAS unsigned* MISC = (volatile LAS unsigned*)(lds + MISC_OFF);
    if (threadIdx.x < 16) MISC[threadIdx.x] = 0u;
    __syncthreads();
    (void)xcd_barrier_post((unsigned*)(a_.ws + WS_CTL), MISC + 8);
#define PH_BEGIN(k) if (ph_lo <= (k) && (k) < ph_hi) { \
        CArgs* ap = (CArgs*)__builtin_amdgcn_kernarg_segment_ptr(); asm volatile("" : "+s"(ap)); CArgs& a = *ap; \
        int tid = threadIdx.x; asm volatile("" : "+v"(tid)); int G_ = gridDim.x, bid = blockIdx.x; asm volatile("" : "+s"(G_), "+s"(bid)); \
        const int lane = tid & 63, wave = __builtin_amdgcn_readfirstlane(tid >> 6), gw = bid * NWAVES + wave, NGW = G_ * NWAVES; (void)lane; (void)gw; (void)NGW; \
        unsigned char* ws = a.ws; float* XR = a.out + O_Y; const float* MOD = (const float*)(ws + WS_MOD); (void)XR; (void)MOD; \
        bf16* H = (bf16*)(ws + WS_H); bf16* BIG = (bf16*)(ws + WS_BIG); bf16* GB = (bf16*)(ws + WS_G); (void)H; (void)BIG; (void)GB;
#define PH_END(k) if ((k) + 1 < ph_hi) { if (ph_hi > 1000) grid.sync(); else { XcdBarrier bar; bar.bar = (unsigned*)(ws + WS_CTL); bar.x = xb_xcc_id(); bar.st = (volatile LAS unsigned*)(lds + MISC_OFF) + 8; xcd_barrier(bar); } } }
#define RUN_GEMM() do { pg8::StaticOrder S; S.init(gm.M, gm.N, G_, bid); pg8::gemm_phase<pg8::EpiGen, pg8::StaticOrder, true, true>(lds, gm, S, E); } while (0)
#define EPI0 pg8::EpiGen E{0, 0, nullptr, 0, nullptr, nullptr, nullptr}
#define RUN_RES_GEMM(Aptr, Wptr, KK, GATE, MODE1, BASE) do { \
        { pg8::Gemm gm{(Aptr), (Wptr), TP, 1024, (KK), (KK)}; EPI0; E.mode = (MODE1); E.F = XR; E.aux = (GATE); E.aux2 = const_cast<float*>(BASE); pg8::StaticOrder S; S.init(TP, 1024, G_, bid, 0, 1); pg8::gemm_phase<pg8::EpiGen, pg8::StaticOrder, true, true>(lds, gm, S, E); } \
        { pg8::Gemm gm{(Aptr), (Wptr), TS, 1024, (KK) / NSPLIT, (KK)}; EPI0; E.mode = 3; E.F = (float*)(ws + WS_PART); E.aux = (GATE); pg8::StaticOrder S; S.init(TS, 1024, G_, bid, TP / 256, NSPLIT); pg8::gemm_phase<pg8::EpiGen, pg8::StaticOrder, true, true>(lds, gm, S, E); } } while (0)

    PH_BEGIN(0) for (int rep = 0; rep < (PROBE == 0 ? 2 : 1); ++rep) p0_prologue(a, lds, gw, NGW, wave, lane); PH_END(0)
    PH_BEGIN(1) { pg8::Gemm gm{(const bf16*)(ws + WS_CS), (const bf16*)(ws + WS_WADA), 256, NMODC, 1024, 1024}; EPI0; E.mode = 2; E.F = (float*)(ws + WS_MOD); E.aux = a.in[7]; RUN_GEMM(); } PH_END(1)
    PH_BEGIN(2) normmod_phase(a.in[0], a.in[1], a.in[8], MOD + 0, MOD + 1024, H, XR, nullptr, gw, NGW, lane); PH_END(2)
    PH_BEGIN(3) { pg8::Gemm gm{H, (const bf16*)(ws + WS_WGIN), T, 4096, 1024, 1024}; EPI0; E.mode = 16; E.act = 1; E.O = BIG; E.ldc = 4096; E.aux2 = (float*)(ws + WS_STATS); RUN_GEMM(); } PH_END(3)
    PH_BEGIN(4) for (int rep = 0; rep < (PROBE == 4 ? 2 : 1); ++rep) for (int u = bid; u < 1024 + 128; u += G_) { if (u < 1024) gate_prompt_unit(a, lds, u, tid); else gate_sample_unit(a, u - 1024, tid); } PH_END(4)
    PH_BEGIN(5) RUN_RES_GEMM(GB, (const bf16*)(ws + WS_WGOUT), 2048, MOD + 2048, 5, a.in[0]); PH_END(5)
    PH_BEGIN(6) normmod_phase(XR, XR + (size_t)TP * D, a.in[9], MOD + 3072, MOD + 4096, H, nullptr, (const float*)(ws + WS_PART), gw, NGW, lane); PH_END(6)
    PH_BEGIN(7) { pg8::Gemm gm{H, (const bf16*)(ws + WS_WM1), T, 4096, 1024, 1024}; EPI0; E.mode = 0; E.act = 2; E.O = BIG; E.ldc = 4096; for (int rep = 0; rep < (PROBE == 7 ? 2 : 1); ++rep) RUN_GEMM(); } PH_END(7)
    PH_BEGIN(8) RUN_RES_GEMM(BIG, (const bf16*)(ws + WS_WM2), 4096, MOD + 5120, 1, (const float*)nullptr); PH_END(8)
    PH_BEGIN(9) normmod_phase(XR, XR + (size_t)TP * D, a.in[8] + 1024, MOD + 6144, MOD + 6144 + 1024, H, nullptr, (const float*)(ws + WS_PART), gw, NGW, lane); PH_END(9)
    PH_BEGIN(10) { pg8::Gemm gm{H, (const bf16*)(ws + WS_WSIN), T, NPROJ_PAD, 1024, 1024}; EPI0; E.mode = 32; E.act = 0; E.O = BIG; E.ldc = ZXP; E.aux2 = (float*)(ws + WS_DT); RUN_GEMM(); } PH_END(10)
    PH_BEGIN(11) { for (int u = bid; u < 256; u += G_) { const int xg = u & 7, sl = u >> 3; ssd_prompt_unit(a, lds, sl >> 2, xg * 4 + (sl & 3), tid); }     int tid2 = threadIdx.x; asm volatile("" : "+v"(tid2)); ssd_sample_units(a, lds, bid, G_, tid2); PROBE12_EXTRA } PH_END(11)
    PH_BEGIN(12) groupnorm_phase(GB, (const float*)(ws + WS_SS), gw, NGW, lane); PH_END(12)
    PH_BEGIN(13) RUN_RES_GEMM(GB, (const bf16*)(ws + WS_WSOUT), 2048, MOD + 6144 + 2048, 1, (const float*)nullptr); PH_END(13)
    PH_BEGIN(14) normmod_phase(XR, XR + (size_t)TP * D, a.in[9] + 1024, MOD + 6144 + 3072, MOD + 6144 + 4096, H, nullptr, (const float*)(ws + WS_PART), gw, NGW, lane); PH_END(14)
    PH_BEGIN(15) { pg8::Gemm gm{H, (const bf16*)(ws + WS_WM1) + (size_t)4096 * 1024, T, 4096, 1024, 1024}; EPI0; E.mode = 0; E.act = 2; E.O = BIG; E.ldc = 4096; RUN_GEMM(); } PH_END(15)
    PH_BEGIN(16) RUN_RES_GEMM(BIG, (const bf16*)(ws + WS_WM2) + (size_t)1024 * 4096, 4096, MOD + 6144 + 5120, 1, (const float*)nullptr); PH_END(16)
    PH_BEGIN(17) finalnorm_phase(XR, a.in[26], (const float*)(ws + WS_PART), gw, NGW, lane); PH_END(17)
}

#ifndef MK_PER_PHASE
#define MK_PER_PHASE 0
#endif
extern "C" void kernel_launch(void* const* d_in, const int* in_sizes, int n_in, void* d_out, int out_size, void* d_ws, size_t ws_size, hipStream_t stream) {
    static int grid = 0;
    if (grid == 0) {
        if (n_in != 27 || (size_t)out_size != O_END || ws_size < WS_END) { fprintf(stderr, "kernel_launch: unexpected shapes: n_in %d out %d ws %zu (need %zu)\n", n_in, out_size, ws_size, (size_t)WS_END); grid = -1; return; }
        int dev = 0, cus = 0, per_cu = 0;
        if (hipGetDevice(&dev) != hipSuccess || hipDeviceGetAttribute(&cus, hipDeviceAttributeMultiprocessorCount, dev) != hipSuccess) { grid = -1; return; }
        if (hipFuncSetAttribute((const void*)mk_fwd, hipFuncAttributeMaxDynamicSharedMemorySize, LDS_BYTES) != hipSuccess) { fprintf(stderr, "kernel_launch: hipFuncSetAttribute failed\n"); grid = -1; return; }
        if (hipOccupancyMaxActiveBlocksPerMultiprocessor(&per_cu, (const void*)mk_fwd, NTHR, LDS_BYTES) != hipSuccess || per_cu < 1) { fprintf(stderr, "kernel_launch: occupancy query says %d\n", per_cu); per_cu = 1; }
        (void)hipGetLastError();
        grid = cus * 1;
    }
    if (grid < 0) return;
    if (hipMemsetAsync((char*)d_ws + WS_CTL, 0, CTL_BYTES, stream) != hipSuccess) { fprintf(stderr, "kernel_launch: memset of the control words failed\n"); return; }
    Args a{};
    for (int i = 0; i < 27; ++i) a.in[i] = (const float*)d_in[i];
    a.out = (float*)d_out; a.ws = (unsigned char*)d_ws;
#if MK_PER_PHASE
    for (int ph = 0; ph < NPH; ++ph) {
        a.ph_lo = ph; a.ph_hi = ph + 1;
        hipLaunchKernelGGL(mk_fwd, dim3(grid), dim3(NTHR), LDS_BYTES, stream, a);
    }
#else
    a.ph_lo = 0; a.ph_hi = NPH;
    void* args[] = {&a};
    hipError_t e = hipLaunchCooperativeKernel((const void*)mk_fwd, dim3(grid), dim3(NTHR), args, LDS_BYTES, stream);
    if (e != hipSuccess) fprintf(stderr, "kernel_launch: cooperative launch failed: %s (grid %d)\n", hipGetErrorString(e), grid);
#endif
}
```

```cpp
#include <hip/hip_runtime.h>
#include <hip/hip_cooperative_groups.h>
#include <cstdio>
#include <cstdint>
namespace cg = cooperative_groups;
namespace pg8 {
#define PG8_LAS __attribute__((address_space(3)))
typedef unsigned short bf16_t;
typedef short bf16x8 __attribute__((ext_vector_type(8)));
typedef float f32x4 __attribute__((ext_vector_type(4)));
typedef unsigned u32x4 __attribute__((ext_vector_type(4)));
constexpr int BM = 256, BK = 64, HALF = 128, HTB = HALF * BK * 2  , STAGE_BYTES = 8 * HTB, NXCD = 8, WGM = 8;

__host__ __device__ __forceinline__ int lds_byte(int r, int c) { const int st = (r >> 4) * 2 + (c >> 5), rr = r & 15, cc = c & 31, ob = rr * 64 + cc * 2; return st * 1024 + (ob ^ (((ob >> 9) & 1) << 5)); }
__host__ __device__ __forceinline__ void stage_rc(int b, int& R, int& C) { const int st = b / 1024, sb = b % 1024, swz = sb ^ (((sb >> 9) & 1) << 5); R = (st >> 1) * 16 + swz / 64; C = (st & 1) * 32 + (swz % 64) / 2; }
__host__ __device__ __forceinline__ int perm32(int rho) { const int n = rho >> 4, i = rho & 15; return 8 * (i >> 2) + 4 * n + (i & 3); }

struct Unit { int pm, pn, ks; };
struct Gemm { const bf16_t* A; const bf16_t* Bt; int M, N, K, ld; };

struct StaticOrder {
    int nM, nN, nwg, G, c, pm0, nsplit;
    __host__ __device__ void init(int M, int N, int G_, int c_, int pm0_ = 0, int nsplit_ = 1) { nM = M / BM; nN = N / BM; nwg = nM * nN; G = G_; c = c_; pm0 = pm0_; nsplit = nsplit_; }
    __host__ __device__ bool next(int i, Unit& u) const {
        const long L = (long)i * G + c; if (L >= (long)nwg * nsplit) return false;
        if (nsplit > 1) { const int ti = (int)L % nwg; u.ks = (int)L / nwg; u.pm = pm0 + ti % nM; u.pn = ti / nM; return true; }
        int wgid = (int)L; { const int q = nwg / NXCD, r = nwg % NXCD, xcd = wgid % NXCD, off = wgid / NXCD; wgid = (xcd < r ? xcd * (q + 1) : r * (q + 1) + (xcd - r) * q) + off; }
        const int nig = WGM * nN, gid = wgid / nig, fm = gid * WGM, gsz = (nM - fm) < WGM ? (nM - fm) : WGM;
        u.pm = pm0 + fm + ((wgid % nig) % gsz); u.pn = (wgid % nig) / gsz; u.ks = 0; return true;
    }
    __device__ __forceinline__ void a_ready(const Unit&) const {}
    __device__ __forceinline__ void done(const Unit&) const {}
};
__device__ __forceinline__ unsigned cvt_pk_bf16(float lo, float hi) { unsigned r; asm volatile("v_cvt_pk_bf16_f32 %0, %1, %2" : "=v"(r) : "v"(lo), "v"(hi)); return r; }
typedef float f32x2 __attribute__((ext_vector_type(2)));
constexpr int EPI_TP = 16384;
__device__ __forceinline__ void act_gelu_tanh8(f32x2 (&x)[4]) {
    f32x2 t[4];
#pragma unroll
    for (int j = 0; j < 4; ++j) t[j] = x[j] * x[j];
#pragma unroll
    for (int j = 0; j < 4; ++j) t[j] = t[j] * (-2.3022082f * 0.044715f) + (-2.3022082f);
#pragma unroll
    for (int j = 0; j < 4; ++j) t[j] = t[j] * x[j];
#pragma unroll
    for (int j = 0; j < 4; ++j) { t[j].x = __builtin_amdgcn_exp2f(t[j].x); t[j].y = __builtin_amdgcn_exp2f(t[j].y); }
#pragma unroll
    for (int j = 0; j < 4; ++j) t[j] = t[j] + 1.0f;
#pragma unroll
    for (int j = 0; j < 4; ++j) { t[j].x = __builtin_amdgcn_rcpf(t[j].x); t[j].y = __builtin_amdgcn_rcpf(t[j].y); }
#pragma unroll
    for (int j = 0; j < 4; ++j) x[j] = x[j] * t[j];
}
struct EpiGen {
    static constexpr bool PERM = true, AFTER_DRAIN = false;
    int mode;
    int act;
    bf16_t* O; int ldc;
    float* F;
    const float* aux;
    float* aux2;
    __device__ __forceinline__ void operator()(const f32x4 (&acc)[2][2][4][2], const Unit& u, int wr, int wc, int fr, int fq) const {
        const int row0 = u.pm * BM + wr * 64 + fr;
        const int col0 = u.pn * BM + wc * 32 + 8 * fq;
        const int md = mode & 15;
        if (md == 0) {
            const bool dtt = (mode & 32) && (u.pn == 24);
            const bool st = (mode & 16) && (u.pn >= 8);
#pragma unroll
            for (int ai = 0; ai < 2; ++ai)
#pragma unroll
                for (int m = 0; m < 4; ++m) {
                    const int row = row0 + ai * HALF + m * 16;
                    float s = 0.f, q = 0.f;
#pragma unroll
                    for (int bj = 0; bj < 2; ++bj) {
                        f32x4 v0 = acc[ai][bj][m][0], v1 = acc[ai][bj][m][1];
                        if (act == 1) {
                            { f32x2 p[4] = {(f32x2){v0[0], v0[1]}, (f32x2){v0[2], v0[3]}, (f32x2){v1[0], v1[1]}, (f32x2){v1[2], v1[3]}}; act_gelu_tanh8(p);
                              v0 = (f32x4){p[0].x, p[0].y, p[1].x, p[1].y}; v1 = (f32x4){p[2].x, p[2].y, p[3].x, p[3].y}; }
                        } else if (act == 2) {
#pragma unroll
                            for (int e = 0; e < 4; ++e) { const float a = v0[e] > 0.f ? v0[e] : 0.f, b = v1[e] > 0.f ? v1[e] : 0.f; v0[e] = a * a; v1[e] = b * b; }
                        }
                        if (dtt) {
                            if (bj == 0 && wc == 0) { float* d = aux2 + (size_t)row * 32 + 8 * fq; *(f32x4*)d = v0; *(f32x4*)(d + 4) = v1; }
                        } else {
                            u32x4 w; w.x = cvt_pk_bf16(v0[0], v0[1]); w.y = cvt_pk_bf16(v0[2], v0[3]); w.z = cvt_pk_bf16(v1[0], v1[1]); w.w = cvt_pk_bf16(v1[2], v1[3]);
                            *(u32x4*)(O + (size_t)row * ldc + col0 + bj * HALF) = w;
                        }
                        if (st) {
#pragma unroll
                            for (int e = 0; e < 4; ++e) { s += v0[e] + v1[e]; q += v0[e] * v0[e] + v1[e] * v1[e]; }
                        }
                    }
                    if (st) {
                        s += __shfl_xor(s, 16); s += __shfl_xor(s, 32); q += __shfl_xor(q, 16); q += __shfl_xor(q, 32);
                        if (fq == 0) { atomicAdd(aux2 + 2 * (size_t)row, s); atomicAdd(aux2 + 2 * (size_t)row + 1, q); }
                    }
                }
        } else if (md == 1 || md == 3 || md == 5) {
#pragma unroll
            for (int ai = 0; ai < 2; ++ai)
#pragma unroll
                for (int m = 0; m < 4; ++m) {
                    const int row = row0 + ai * HALF + m * 16;
                    const int seq = row < EPI_TP ? (row >> 11) : 8 + ((row - EPI_TP) >> 3);
                    const float* gr = aux + (size_t)seq * 12288;
                    float* fo = F + (size_t)row * 1024;
#pragma unroll
                    for (int bj = 0; bj < 2; ++bj) {
                        const int c = col0 + bj * HALF;
                        const f32x4 g0 = *(const f32x4*)(gr + c), g1 = *(const f32x4*)(gr + c + 4);
                        if (md != 3) {
                            const float* bo = md == 5 ? aux2 + (size_t)row * 1024 : fo;
                            const f32x4 b0 = *(const f32x4*)(bo + c), b1 = *(const f32x4*)(bo + c + 4);
                            *(f32x4*)(fo + c) = b0 + g0 * acc[ai][bj][m][0];
                            *(f32x4*)(fo + c + 4) = b1 + g1 * acc[ai][bj][m][1];
                        } else {
                            float* po = F + ((size_t)u.ks * 1024 + (row - EPI_TP)) * 1024 + c;
                            *(f32x4*)po = g0 * acc[ai][bj][m][0];
                            *(f32x4*)(po + 4) = g1 * acc[ai][bj][m][1];
                        }
                    }
                }
        } else {
#pragma unroll
            for (int ai = 0; ai < 2; ++ai)
#pragma unroll
                for (int m = 0; m < 4; ++m) {
                    const int row = row0 + ai * HALF + m * 16;
                    float* fo = F + (size_t)row * 12288;
#pragma unroll
                    for (int bj = 0; bj < 2; ++bj) {
                        const int c = col0 + bj * HALF;
                        const f32x4 b0 = *(const f32x4*)(aux + c), b1 = *(const f32x4*)(aux + c + 4);
                        *(f32x4*)(fo + c) = b0 + acc[ai][bj][m][0];
                        *(f32x4*)(fo + c + 4) = b1 + acc[ai][bj][m][1];
                    }
                }
        }
    }
};

template <class Epi, class Sched, bool ALIGN_EPI = false, bool SP2 = false>
__device__ __forceinline__ void gemm_phase(PG8_LAS unsigned char* lds, const Gemm g, const Sched& S, const Epi& E) {
    int tid_ = threadIdx.x; asm volatile("" : "+v"(tid_));
    const int tid = tid_, wid = __builtin_amdgcn_readfirstlane(tid >> 6), lane = tid & 63, wr = wid >> 2, wc = wid & 3, fr = lane & 15, fq = lane >> 4;
    const int K = g.ld, nt = g.K / BK;
    unsigned voffA[2], voffB[2];
#pragma unroll
    for (int i = 0; i < 2; ++i) { int R, C; stage_rc(tid * 16 + i * 8192, R, C); const int Rb = Epi::PERM ? ((R & ~31) + perm32(R & 31)) : R;
        voffA[i] = (unsigned)(R * K + C) * 2u; voffB[i] = (unsigned)(Rb * K + C) * 2u; }
    const size_t kstep = (size_t)(BK * 2);
    const size_t hstep = (size_t)HALF * K * 2;
    const size_t tstep = 2 * hstep;
    const unsigned ldsw = (unsigned)wid * 1024u;
    const int aoff = lds_byte(wr * 64 + fr, fq * 8), boff = lds_byte(wc * 32 + fr, fq * 8);
#define PG8_SA(b, h) (((b) * 2 + (h)) * HTB)
#define PG8_SB(b, h) ((4 + (b) * 2 + (h)) * HTB)
#define PG8_STAGE(bufoff, gbase, voff) do { _Pragma("unroll") for (int _i = 0; _i < 2; ++_i) \
        __builtin_amdgcn_global_load_lds((const unsigned*)((const char*)(gbase) + (voff)[_i]), (PG8_LAS unsigned*)(lds + (bufoff) + ldsw + _i * 8192), 16, 0, 0); } while (0)
#define PG8_LDA(dst, b, h) do { _Pragma("unroll") for (int m = 0; m < 4; ++m) _Pragma("unroll") for (int k = 0; k < 2; ++k) dst[m][k] = *(const PG8_LAS bf16x8*)(lds + PG8_SA(b, h) + aoff + m * 2048 + k * 1024); } while (0)
#define PG8_LDB(dst, b, h) do { _Pragma("unroll") for (int n = 0; n < 2; ++n) _Pragma("unroll") for (int k = 0; k < 2; ++k) dst[n][k] = *(const PG8_LAS bf16x8*)(lds + PG8_SB(b, h) + boff + n * 2048 + k * 1024); } while (0)
#define PG8_MMA(ai, bj, At, Bt) do { __builtin_amdgcn_s_setprio(1); _Pragma("unroll") for (int m = 0; m < 4; ++m) _Pragma("unroll") for (int n = 0; n < 2; ++n) _Pragma("unroll") for (int k = 0; k < 2; ++k) \
        acc[ai][bj][m][n] = __builtin_amdgcn_mfma_f32_16x16x32_bf16(Bt[n][k], At[m][k], acc[ai][bj][m][n], 0, 0, 0); __builtin_amdgcn_s_setprio(0); } while (0)
#define PG8_WAIT_V(n) asm volatile("s_waitcnt vmcnt(" #n ")" ::: "memory")
#define PG8_WAIT_L(n) asm volatile("s_waitcnt lgkmcnt(" #n ")" ::: "memory")
#define PG8_BAR __builtin_amdgcn_s_barrier()
#define PG8_SCHED __builtin_amdgcn_sched_barrier(0)
    Unit cur, nxt; int ui = 0;
    if (!S.next(0, cur)) return;
    f32x4 acc[2][2][4][2];
#pragma unroll
    for (int a = 0; a < 2; ++a)
#pragma unroll
        for (int b = 0; b < 2; ++b)
#pragma unroll
            for (int m = 0; m < 4; ++m)
#pragma unroll
                for (int n = 0; n < 2; ++n) acc[a][b][m][n] = (f32x4){0.f, 0.f, 0.f, 0.f};
    bf16x8 At[4][2], B0[2][2], B1[2][2];
    const size_t ksb = (size_t)g.K * 2;
    const char* cA = (const char*)g.A + (size_t)cur.pm * tstep + cur.ks * ksb; const char* cB = (const char*)g.Bt + (size_t)cur.pn * tstep + cur.ks * ksb;
    S.a_ready(cur);
    if constexpr (SP2) {
        PG8_STAGE(PG8_SB(0, 0), cB, voffB); PG8_STAGE(PG8_SB(0, 1), cB + hstep, voffB); PG8_STAGE(PG8_SA(0, 0), cA, voffA); PG8_STAGE(PG8_SA(0, 1), cA + hstep, voffA);
        if (wr == 1) PG8_BAR;
        PG8_WAIT_V(2); PG8_BAR;
        PG8_STAGE(PG8_SB(1, 0), cB + kstep, voffB); PG8_STAGE(PG8_SA(1, 0), cA + kstep, voffA); PG8_STAGE(PG8_SB(1, 1), cB + hstep + kstep, voffB);
        PG8_WAIT_V(6); PG8_BAR;
    } else {
        PG8_STAGE(PG8_SB(0, 0), cB, voffB); PG8_STAGE(PG8_SA(0, 0), cA, voffA); PG8_STAGE(PG8_SB(0, 1), cB + hstep, voffB); PG8_STAGE(PG8_SA(0, 1), cA + hstep, voffA);
        if (wr == 1) PG8_BAR;
        PG8_WAIT_V(4); PG8_BAR;
        PG8_STAGE(PG8_SB(1, 0), cB + kstep, voffB); PG8_STAGE(PG8_SA(1, 0), cA + kstep, voffA); PG8_STAGE(PG8_SB(1, 1), cB + hstep + kstep, voffB);
        PG8_WAIT_V(6); PG8_BAR;
    }
    for (;;) {
        const bool has_next = S.next(ui + 1, nxt);
        const char* nA = has_next ? (const char*)g.A + (size_t)nxt.pm * tstep + nxt.ks * ksb : cA; const char* nB = has_next ? (const char*)g.Bt + (size_t)nxt.pn * tstep + nxt.ks * ksb : cB;
        for (int t = 0; t < nt; t += 2) {
            const bool last = (t == nt - 2);
            const char* a1 = cA + (size_t)(t + 1) * kstep;
            const char* a2 = last ? nA : cA + (size_t)(t + 2) * kstep; const char* b2 = last ? nB : cB + (size_t)(t + 2) * kstep;
            const char* a3 = a2 + kstep; const char* b3 = b2 + kstep;
            if (last && has_next) S.a_ready(nxt);
            if constexpr (SP2) {
            PG8_LDB(B0, 0, 0); PG8_LDB(B1, 0, 1); PG8_SCHED; PG8_LDA(At, 0, 0); PG8_STAGE(PG8_SA(1, 1), a1 + hstep, voffA);
            PG8_WAIT_V(8); PG8_WAIT_L(0); PG8_BAR; PG8_MMA(0, 0, At, B0); PG8_MMA(0, 1, At, B1); PG8_BAR; PG8_SCHED;
            PG8_LDA(At, 0, 1); PG8_STAGE(PG8_SB(0, 0), b2, voffB); PG8_STAGE(PG8_SB(0, 1), b2 + hstep, voffB); PG8_STAGE(PG8_SA(0, 0), a2, voffA);
            PG8_WAIT_V(8); PG8_WAIT_L(0); PG8_BAR; PG8_MMA(1, 0, At, B0); PG8_MMA(1, 1, At, B1); PG8_BAR; PG8_SCHED;
            PG8_LDB(B0, 1, 0); PG8_LDB(B1, 1, 1); PG8_SCHED; PG8_LDA(At, 1, 0); PG8_STAGE(PG8_SA(0, 1), a2 + hstep, voffA);
            PG8_WAIT_V(8); PG8_WAIT_L(0); PG8_BAR; PG8_MMA(0, 0, At, B0); PG8_MMA(0, 1, At, B1); PG8_BAR; PG8_SCHED;
            PG8_LDA(At, 1, 1); PG8_STAGE(PG8_SB(1, 0), b3, voffB); PG8_STAGE(PG8_SB(1, 1), b3 + hstep, voffB); PG8_STAGE(PG8_SA(1, 0), a3, voffA);
            PG8_WAIT_V(8); PG8_WAIT_L(0); PG8_BAR; PG8_MMA(1, 0, At, B0); PG8_MMA(1, 1, At, B1); PG8_BAR; PG8_SCHED;
            } else {
            PG8_LDB(B0, 0, 0); PG8_SCHED; PG8_LDA(At, 0, 0); PG8_STAGE(PG8_SA(1, 1), a1 + hstep, voffA);
            PG8_WAIT_L(8); PG8_BAR; PG8_WAIT_L(0); PG8_MMA(0, 0, At, B0); PG8_BAR; PG8_SCHED;
            PG8_LDB(B1, 0, 1); PG8_STAGE(PG8_SB(0, 0), b2, voffB);
            PG8_BAR; PG8_WAIT_L(0); PG8_MMA(0, 1, At, B1); PG8_BAR;
            PG8_LDA(At, 0, 1); PG8_STAGE(PG8_SA(0, 0), a2, voffA);
            PG8_BAR; PG8_WAIT_L(0); PG8_MMA(1, 0, At, B0); PG8_BAR; PG8_SCHED;
            PG8_STAGE(PG8_SB(0, 1), b2 + hstep, voffB);
            PG8_WAIT_V(6); PG8_BAR; PG8_MMA(1, 1, At, B1); PG8_BAR;
            PG8_LDB(B0, 1, 0); PG8_SCHED; PG8_LDA(At, 1, 0); PG8_STAGE(PG8_SA(0, 1), a2 + hstep, voffA);
            PG8_WAIT_L(8); PG8_BAR; PG8_WAIT_L(0); PG8_MMA(0, 0, At, B0); PG8_BAR; PG8_SCHED;
            PG8_LDB(B1, 1, 1); PG8_STAGE(PG8_SB(1, 0), b3, voffB);
            PG8_BAR; PG8_WAIT_L(0); PG8_MMA(0, 1, At, B1); PG8_BAR;
            PG8_LDA(At, 1, 1); PG8_STAGE(PG8_SA(1, 0), a3, voffA);
            PG8_BAR; PG8_WAIT_L(0); PG8_MMA(1, 0, At, B0); PG8_BAR; PG8_SCHED;
            PG8_STAGE(PG8_SB(1, 1), b3 + hstep, voffB);
            PG8_WAIT_V(6); PG8_BAR; PG8_MMA(1, 1, At, B1); PG8_BAR;
            }
        }
        if constexpr (ALIGN_EPI) { if (wr == 0) PG8_BAR; }
        if constexpr (!Epi::AFTER_DRAIN) { E(acc, cur, wr, wc, fr, fq); S.done(cur); }
        if (!has_next) break;
#pragma unroll
        for (int a = 0; a < 2; ++a)
#pragma unroll
            for (int b = 0; b < 2; ++b)
#pragma unroll
                for (int m = 0; m < 4; ++m)
#pragma unroll
                    for (int n = 0; n < 2; ++n) acc[a][b][m][n] = (f32x4){0.f, 0.f, 0.f, 0.f};
        cur = nxt; cA = nA; cB = nB; ++ui;
        if constexpr (ALIGN_EPI) { if (wr == 1) PG8_BAR; }
    }
    PG8_WAIT_V(0);
    if constexpr (!ALIGN_EPI) { if (wr == 0) PG8_BAR; }
    PG8_BAR;
    if constexpr (Epi::AFTER_DRAIN) { E.fused(acc, cur, wr, wc, fr, fq, lds, wid, lane); S.done(cur); }
#undef PG8_SA
#undef PG8_SB
#undef PG8_STAGE
#undef PG8_LDA
#undef PG8_LDB
#undef PG8_MMA
#undef PG8_WAIT_V
#undef PG8_WAIT_L
#undef PG8_BAR
#undef PG8_SCHED
}
}

#define LAS __attribute__((address_space(3)))
typedef unsigned short bf16;
typedef unsigned v4u __attribute__((ext_vector_type(4)));
typedef unsigned v2u __attribute__((ext_vector_type(2)));
typedef float f32x4 __attribute__((ext_vector_type(4)));
typedef float f32x2 __attribute__((ext_vector_type(2)));
typedef short bf16x8 __attribute__((ext_vector_type(8)));
typedef LAS unsigned char* ldsp;

constexpr int NWAVES = 8, NTHR = 512;
constexpr int D = 1024, TP = 16384, TS = 1024, T = TP + TS, NSEQ = 136;
constexpr int DGM = 2048, DIN = 2048, CONVD = 4096, NPROJ = 6176, NPROJ_PAD = 6400, ZXP = 6144, DFF = 4096, NMODC = 12288;
constexpr float EPS = 1e-6f;
constexpr int LDS_BYTES = 163840;

constexpr size_t MiB = 1u << 20;
constexpr size_t WS_WADA = 0;
constexpr size_t WS_WGIN = WS_WADA + 24 * MiB;
constexpr size_t WS_WGOUT = WS_WGIN + 8 * MiB;
constexpr size_t WS_WSIN = WS_WGOUT + 4 * MiB;
constexpr size_t WS_WSOUT = WS_WSIN + 13 * MiB;
constexpr size_t WS_WM1 = WS_WSOUT + 4 * MiB;
constexpr size_t WS_WM2 = WS_WM1 + 16 * MiB;
constexpr size_t WS_CS = WS_WM2 + 16 * MiB;
constexpr size_t WS_MOD = WS_CS + 1 * MiB;
constexpr size_t WS_H = WS_MOD + 12 * MiB;
constexpr size_t WS_BIG = WS_H + 34 * MiB;
constexpr size_t WS_G = WS_BIG + 204 * MiB;
constexpr size_t WS_DT = WS_G + 68 * MiB;
constexpr size_t WS_STATS = WS_DT + 3 * MiB;
constexpr size_t WS_SS = WS_STATS + 1 * MiB;
constexpr size_t WS_CTL = WS_SS + 3 * MiB;
constexpr size_t CTL_BYTES = 16384;
constexpr size_t WS_PART = WS_CTL + 1 * MiB;
constexpr int NSPLIT = 8;
constexpr size_t WS_END = WS_PART + 32 * MiB;
constexpr int MISC_OFF = LDS_BYTES - 64;

constexpr size_t O_Y = 0;
constexpr size_t O_VP = (size_t)T * D;
constexpr size_t O_VS = O_VP + (size_t)8 * 128 * 2048;
constexpr size_t O_SP = O_VS + (size_t)128 * 8 * 2048;
constexpr size_t O_CP = O_SP + (size_t)8 * 32 * 64 * 128;
constexpr size_t O_SSS = O_CP + (size_t)8 * 3 * 4096;
constexpr size_t O_CSS = O_SSS + (size_t)128 * 32 * 64 * 128;
constexpr size_t O_END = O_CSS + (size_t)128 * 3 * 4096;

struct Args { const float* in[27]; float* out; unsigned char* ws; int ph_lo, ph_hi; };
typedef const __attribute__((address_space(4))) Args CArgs;

#define LDS_WAIT() asm volatile("s_waitcnt lgkmcnt(0)" ::: "memory")
#define LDS_BARRIER() do { asm volatile("s_waitcnt lgkmcnt(0)" ::: "memory"); __builtin_amdgcn_s_barrier(); asm volatile("" ::: "memory"); } while (0)
__device__ __forceinline__ unsigned f2bf(float f) { unsigned u = __builtin_bit_cast(unsigned, f); return (u + 0x7fffu + ((u >> 16) & 1u)) >> 16; }
__device__ __forceinline__ unsigned pk2(float lo, float hi) { unsigned r; asm("v_cvt_pk_bf16_f32 %0, %1, %2" : "=v"(r) : "v"(lo), "v"(hi)); return r; }
__device__ __forceinline__ float bf_lo(unsigned w) { return __builtin_bit_cast(float, w << 16); }
__device__ __forceinline__ float bf_hi(unsigned w) { return __builtin_bit_cast(float, w & 0xffff0000u); }
__device__ __forceinline__ float bf1(bf16 b) { return __builtin_bit_cast(float, (unsigned)b << 16); }
__device__ __forceinline__ float wave_sum(float v) {
#pragma unroll
    for (int o = 1; o < 64; o <<= 1) v += __shfl_xor(v, o);
    return v;
}
__device__ __forceinline__ float silu_f(float x) { return x * __builtin_amdgcn_rcpf(1.0f + __builtin_amdgcn_exp2f(-1.4426950409f * x)); }
__device__ __forceinline__ float exp_f(float x) { return __builtin_amdgcn_exp2f(1.4426950409f * x); }
__device__ __forceinline__ float softplus_f(float x) { return x > 20.f ? x : 0.6931471806f * __builtin_amdgcn_logf(1.0f + __builtin_amdgcn_exp2f(1.4426950409f * x)); }
__device__ __forceinline__ int seq_of_row(int row) { return row < TP ? (row >> 11) : 8 + ((row - TP) >> 3); }

__device__ __forceinline__ void p0_transpose_item(const float* W, int K, int N, bf16* WT, int row_off, const float* kscale, LAS float* scr, int item, int lane) {
    const int nblk = N / 32, kb = item / nblk, nb = item % nblk, k0 = 64 * kb, n0 = 32 * nb;
#pragma unroll 8
    for (int i = 0; i < 32; ++i) { const int kk = 2 * i + (lane >> 5); float v = W[(size_t)(k0 + kk) * N + n0 + (lane & 31)]; if (kscale) v *= kscale[k0 + kk]; scr[kk * 33 + (lane & 31)] = v; }
    LDS_WAIT(); asm volatile("" ::: "memory");
    const int c = lane & 7;
#pragma unroll
    for (int j = 0; j < 4; ++j) { const int n = (lane >> 3) + 8 * j; const LAS float* s = scr + (8 * c) * 33 + n;
        v4u o; o.x = pk2(s[0 * 33], s[1 * 33]); o.y = pk2(s[2 * 33], s[3 * 33]); o.z = pk2(s[4 * 33], s[5 * 33]); o.w = pk2(s[6 * 33], s[7 * 33]);
        *(v4u*)(WT + (size_t)(row_off + n0 + n) * K + k0 + 8 * c) = o; }
    LDS_WAIT(); asm volatile("" ::: "memory");
}

constexpr int I_ADA = 16 * 192, I_GIN = 16 * 128, I_GOUT = 32 * 32, I_SIN = 16 * 193, I_SOUT = 32 * 32, I_M1 = 16 * 128, I_M2 = 64 * 32;
constexpr int NITEMS = 2 * I_ADA + I_GIN + I_GOUT + I_SIN + I_SOUT + 2 * I_M1 + 2 * I_M2;
__device__ __forceinline__ void p0_prologue(CArgs& a, ldsp lds, int it_lo, int it_hi, int w, int nw, bool misc, int wave, int lane) {
    unsigned char* ws = a.ws;
    LAS float* scr = (LAS float*)(lds + wave * 16384);
    const int gw = w, NGW = nw;
    for (int it = it_lo + w; it < it_hi; it += nw) {
        int r = it;
        if (r < I_ADA) { p0_transpose_item(a.in[6], 1024, 6144, (bf16*)(ws + WS_WADA), 0, nullptr, scr, r, lane); continue; } r -= I_ADA;
        if (r < I_ADA) { p0_transpose_item(a.in[6] + (size_t)1024 * 6144, 1024, 6144, (bf16*)(ws + WS_WADA), 6144, nullptr, scr, r, lane); continue; } r -= I_ADA;
        if (r < I_GIN) { p0_transpose_item(a.in[10], 1024, 4096, (bf16*)(ws + WS_WGIN), 0, nullptr, scr, r, lane); continue; } r -= I_GIN;
        if (r < I_GOUT) { p0_transpose_item(a.in[15], 2048, 1024, (bf16*)(ws + WS_WGOUT), 0, nullptr, scr, r, lane); continue; } r -= I_GOUT;
        if (r < I_SIN) { p0_transpose_item(a.in[16], 1024, NPROJ, (bf16*)(ws + WS_WSIN), 0, nullptr, scr, r, lane); continue; } r -= I_SIN;
        if (r < I_SOUT) { p0_transpose_item(a.in[23], 2048, 1024, (bf16*)(ws + WS_WSOUT), 0, a.in[22], scr, r, lane); continue; } r -= I_SOUT;
        if (r < I_M1) { p0_transpose_item(a.in[24], 1024, 4096, (bf16*)(ws + WS_WM1), 0, nullptr, scr, r, lane); continue; } r -= I_M1;
        if (r < I_M1) { p0_transpose_item(a.in[24] + (size_t)1024 * 4096, 1024, 4096, (bf16*)(ws + WS_WM1), 4096, nullptr, scr, r, lane); continue; } r -= I_M1;
        if (r < I_M2) { p0_transpose_item(a.in[25], 4096, 1024, (bf16*)(ws + WS_WM2), 0, nullptr, scr, r, lane); continue; } r -= I_M2;
        p0_transpose_item(a.in[25] + (size_t)4096 * 1024, 4096, 1024, (bf16*)(ws + WS_WM2), 1024, nullptr, scr, r, lane);
    }
    if (!misc) return;
    for (int s = gw; s < 256; s += NGW) {
        bf16* o = (bf16*)(ws + WS_CS) + (size_t)s * 1024;
        const float* c = s < 8 ? a.in[2] + (size_t)s * 1024 : a.in[3] + (size_t)(s - 8) * 1024;
#pragma unroll
        for (int j = 0; j < 4; ++j) {
            const int col = lane * 4 + 256 * j; v2u w; w.x = 0u; w.y = 0u;
            if (s < NSEQ) { const f32x4 v = *(const f32x4*)(c + col); w.x = pk2(silu_f(v[0]), silu_f(v[1])); w.y = pk2(silu_f(v[2]), silu_f(v[3])); }
            *(v2u*)(o + col) = w;
        }
    }
    { float* st = (float*)(ws + WS_STATS); for (int i = gw * 64 + lane; i < T * 2; i += NGW * 64) st[i] = 0.f; }
    { v4u* p = (v4u*)((bf16*)(ws + WS_WSIN) + (size_t)NPROJ * 1024); const int n = (NPROJ_PAD - NPROJ) * 1024 / 8; const v4u z = {0u, 0u, 0u, 0u};
      for (int i = gw * 64 + lane; i < n; i += NGW * 64) p[i] = z; }
}

__device__ __forceinline__ void normmod_phase(const float* x0, const float* x1, const float* gamma, const float* shift, const float* scale, bf16* H, float* xcopy, const float* part, int gw, int NGW, int lane) {
    int row = gw; if (row >= T) return;
    f32x4 gm4[4];
#pragma unroll
    for (int j = 0; j < 4; ++j) gm4[j] = *(const f32x4*)(gamma + lane * 4 + 256 * j);
    f32x4 v[4], sc[4], sh[4];
    {
        const float* xr = row < TP ? x0 + (size_t)row * D : x1 + (size_t)(row - TP) * D; const int seq = seq_of_row(row);
#pragma unroll
        for (int j = 0; j < 4; ++j) { const int c = lane * 4 + 256 * j; v[j] = *(const f32x4*)(xr + c); sc[j] = *(const f32x4*)(scale + (size_t)seq * NMODC + c); sh[j] = *(const f32x4*)(shift + (size_t)seq * NMODC + c); }
    }
    for (; row < T; row += NGW) {
        const int nrow = row + NGW;
        f32x4 vn[4], scn[4], shn[4];
        if (nrow < T) {
            const float* xn = nrow < TP ? x0 + (size_t)nrow * D : x1 + (size_t)(nrow - TP) * D; const int seqn = seq_of_row(nrow);
#pragma unroll
            for (int j = 0; j < 4; ++j) { const int c = lane * 4 + 256 * j; vn[j] = *(const f32x4*)(xn + c); scn[j] = *(const f32x4*)(scale + (size_t)seqn * NMODC + c); shn[j] = *(const f32x4*)(shift + (size_t)seqn * NMODC + c); }
        } else {
#pragma unroll
            for (int j = 0; j < 4; ++j) { vn[j] = v[j]; scn[j] = sc[j]; shn[j] = sh[j]; }
        }
        float ss = 0.f;
        if (part && row >= TP) {
            float* xw = const_cast<float*>(x1) + (size_t)(row - TP) * D;
#pragma unroll
            for (int j = 0; j < 4; ++j) {
#pragma unroll
                for (int k = 0; k < NSPLIT; ++k) v[j] += *(const f32x4*)(part + ((size_t)k * 1024 + (row - TP)) * 1024 + lane * 4 + 256 * j);
                *(f32x4*)(xw + lane * 4 + 256 * j) = v[j];
            }
        }
#pragma unroll
        for (int j = 0; j < 4; ++j) ss += (v[j][0] * v[j][0] + v[j][1] * v[j][1]) + (v[j][2] * v[j][2] + v[j][3] * v[j][3]);
        if (xcopy && row >= TP) {
#pragma unroll
            for (int j = 0; j < 4; ++j) *(f32x4*)(xcopy + (size_t)row * D + lane * 4 + 256 * j) = v[j];
        }
        const float rstd = 1.0f / sqrtf(wave_sum(ss) * (1.0f / D) + EPS);
#pragma unroll
        for (int j = 0; j < 4; ++j) {
            const int c = lane * 4 + 256 * j;
            const f32x4 o = v[j] * rstd * gm4[j] * (1.0f + sc[j]) + sh[j];
            v2u w; w.x = pk2(o[0], o[1]); w.y = pk2(o[2], o[3]);
            *(v2u*)(H + (size_t)row * D + c) = w;
        }
#pragma unroll
        for (int j = 0; j < 4; ++j) { v[j] = vn[j]; sc[j] = scn[j]; sh[j] = shn[j]; }
    }
}
__device__ __forceinline__ void finalnorm_phase(float* x, const float* gamma, const float* part, int gw, int NGW, int lane) {
    int row = gw; if (row >= T) return;
    f32x4 gm4[4], v[4];
#pragma unroll
    for (int j = 0; j < 4; ++j) { gm4[j] = *(const f32x4*)(gamma + lane * 4 + 256 * j); v[j] = *(const f32x4*)(x + (size_t)row * D + lane * 4 + 256 * j); }
    for (; row < T; row += NGW) {
        float* xr = x + (size_t)row * D;
        const int nrow = row + NGW; f32x4 vn[4];
#pragma unroll
        for (int j = 0; j < 4; ++j) vn[j] = nrow < T ? *(const f32x4*)(x + (size_t)nrow * D + lane * 4 + 256 * j) : v[j];
        if (part && row >= TP) {
#pragma unroll
            for (int j = 0; j < 4; ++j) {
#pragma unroll
                for (int k = 0; k < NSPLIT; ++k) v[j] += *(const f32x4*)(part + ((size_t)k * 1024 + (row - TP)) * 1024 + lane * 4 + 256 * j);
            }
        }
        float ss = 0.f;
#pragma unroll
        for (int j = 0; j < 4; ++j) ss += (v[j][0] * v[j][0] + v[j][1] * v[j][1]) + (v[j][2] * v[j][2] + v[j][3] * v[j][3]);
        const float rstd = 1.0f / sqrtf(wave_sum(ss) * (1.0f / D) + EPS);
#pragma unroll
        for (int j = 0; j < 4; ++j) { const int c = lane * 4 + 256 * j; *(f32x4*)(xr + c) = v[j] * rstd * gm4[j]; }
#pragma unroll
        for (int j = 0; j < 4; ++j) v[j] = vn[j];
    }
}
__device__ __forceinline__ void groupnorm_phase(bf16* G, const float* SS, int gw, int NGW, int lane) {
    int row = gw; if (row >= T) return;
    v4u w[4]; f32x4 s4[4];
#pragma unroll
    for (int j = 0; j < 4; ++j) { const int c = lane * 8 + 512 * j; w[j] = *(const v4u*)(G + (size_t)row * DIN + c); s4[j] = *(const f32x4*)(SS + (size_t)row * 32 + 4 * (c >> 8)); }
    for (; row < T; row += NGW) {
        bf16* gr = G + (size_t)row * DIN;
        const int nrow = row + NGW; v4u wn[4]; f32x4 sn[4];
#pragma unroll
        for (int j = 0; j < 4; ++j) { const int c = lane * 8 + 512 * j;
            if (nrow < T) { wn[j] = *(const v4u*)(G + (size_t)nrow * DIN + c); sn[j] = *(const f32x4*)(SS + (size_t)nrow * 32 + 4 * (c >> 8)); } else { wn[j] = w[j]; sn[j] = s4[j]; } }
#pragma unroll
        for (int j = 0; j < 4; ++j) {
            const int c = lane * 8 + 512 * j;
            const float rstd = 1.0f / sqrtf(((s4[j][0] + s4[j][1]) + (s4[j][2] + s4[j][3])) * (1.0f / 256.f) + EPS);
            v4u o;
            o.x = pk2(bf_lo(w[j].x) * rstd, bf_hi(w[j].x) * rstd); o.y = pk2(bf_lo(w[j].y) * rstd, bf_hi(w[j].y) * rstd);
            o.z = pk2(bf_lo(w[j].z) * rstd, bf_hi(w[j].z) * rstd); o.w = pk2(bf_lo(w[j].w) * rstd, bf_hi(w[j].w) * rstd);
            *(v4u*)(gr + c) = o;
        }
#pragma unroll
        for (int j = 0; j < 4; ++j) { w[j] = wn[j]; s4[j] = sn[j]; }
    }
}

constexpr int LP = 136;
#define MFMA16(a, b, c) __builtin_amdgcn_mfma_f32_16x16x32_bf16((a), (b), (c), 0, 0, 0)
typedef short s16x4 __attribute__((ext_vector_type(4)));
__device__ __forceinline__ bf16x8 tr_frag(const LAS bf16* tile, int pitch, int k0, int c, int lane) {
    const int g = lane >> 4, q = (lane & 15) >> 2, p = lane & 3;
    const LAS bf16* a0 = tile + (k0 + 8 * g + q) * pitch + 16 * c + 4 * p;
    const s16x4 lo = __builtin_amdgcn_ds_read_tr16_b64_v4i16((LAS s16x4*)a0);
    const s16x4 hi = __builtin_amdgcn_ds_read_tr16_b64_v4i16((LAS s16x4*)(a0 + 4 * pitch));
    return __builtin_shufflevector(lo, hi, 0, 1, 2, 3, 4, 5, 6, 7);
}
__device__ __forceinline__ bf16x8 tr_frag_pair(const LAS bf16* tile, int pitch, int k0, int c2, int n, int lane) {
    const int g = lane >> 4, q = (lane & 15) >> 2, p = lane & 3;
    const LAS bf16* a0 = tile + (k0 + 8 * g + q) * pitch + 32 * c2 + 8 * p + 4 * n;
    const s16x4 lo = __builtin_amdgcn_ds_read_tr16_b64_v4i16((LAS s16x4*)a0);
    const s16x4 hi = __builtin_amdgcn_ds_read_tr16_b64_v4i16((LAS s16x4*)(a0 + 4 * pitch));
    return __builtin_shufflevector(lo, hi, 0, 1, 2, 3, 4, 5, 6, 7);
}
constexpr int VP = 272;
__device__ __forceinline__ void gate_prompt_unit(CArgs& a, ldsp lds, int unit, int tid) {
    const int g = unit & 7, bc = unit >> 3, c = bc & 15, b = bc >> 4, row0 = bc * 128;
    const int wid = tid >> 6, lane = tid & 63, fr = lane & 15, fq = lane >> 4, wr = wid >> 2, wc = wid & 3;
    const bf16* Z = (const bf16*)(a.ws + WS_BIG); bf16* G = (bf16*)(a.ws + WS_G); const float* stats = (const float*)(a.ws + WS_STATS);
    LAS bf16* WsA = (LAS bf16*)lds; LAS bf16* vT = (LAS bf16*)(lds + 128 * LP * 2);
    const int w0 = (tid & 31) * 8, sb = tid >> 5;
    v4u raw[8]; float mu[8], rs[8];
#pragma unroll
    for (int i = 0; i < 8; ++i) {
        const int row = row0 + sb + 16 * i;
        raw[i] = *(const v4u*)(Z + (size_t)row * 4096 + 2048 + g * 256 + w0);
        const float s1 = stats[2 * row], s2 = stats[2 * row + 1];
        mu[i] = s1 * (1.f / 2048.f); rs[i] = s2;
    }
    const float* lng = a.in[11] + g * 256 + w0; const float* lnb = a.in[12] + g * 256 + w0;
    const f32x4 g0 = *(const f32x4*)(lng), g1 = *(const f32x4*)(lng + 4), b0 = *(const f32x4*)(lnb), b1 = *(const f32x4*)(lnb + 4);
    const float* w_s = a.in[13] + (size_t)g * 16384;
    {
        const int t0 = tid >> 5, s0 = (tid & 31) * 4;
#pragma unroll
        for (int i = 0; i < 8; ++i) {
            const int t = t0 + 16 * i;
            const f32x4 v = *(const f32x4*)(w_s + t * 128 + s0);
            v2u w; w.x = pk2(s0 <= t ? v[0] : 0.f, s0 + 1 <= t ? v[1] : 0.f); w.y = pk2(s0 + 2 <= t ? v[2] : 0.f, s0 + 3 <= t ? v[3] : 0.f);
            *(LAS v2u*)(WsA + t * LP + s0) = w;
        }
    }
#pragma unroll
    for (int i = 0; i < 8; ++i) {
        const int s = sb + 16 * i;
        const float m = mu[i], var = rs[i] * (1.f / 2048.f) - m * m, rstd = 1.0f / sqrtf(var + EPS);
        f32x4 v0, v1;
        v0[0] = (bf_lo(raw[i].x) - m) * rstd * g0[0] + b0[0]; v0[1] = (bf_hi(raw[i].x) - m) * rstd * g0[1] + b0[1];
        v0[2] = (bf_lo(raw[i].y) - m) * rstd * g0[2] + b0[2]; v0[3] = (bf_hi(raw[i].y) - m) * rstd * g0[3] + b0[3];
        v1[0] = (bf_lo(raw[i].z) - m) * rstd * g1[0] + b1[0]; v1[1] = (bf_hi(raw[i].z) - m) * rstd * g1[1] + b1[1];
        v1[2] = (bf_lo(raw[i].w) - m) * rstd * g1[2] + b1[2]; v1[3] = (bf_hi(raw[i].w) - m) * rstd * g1[3] + b1[3];
        { v4u w; w.x = pk2(v0[0], v0[1]); w.y = pk2(v0[2], v0[3]); w.z = pk2(v1[0], v1[1]); w.w = pk2(v1[2], v1[3]); *(LAS v4u*)(vT + s * VP + w0) = w; }
        if (c == 15) { float* o = a.out + O_VP + ((size_t)(b * 128 + s)) * 2048 + g * 256 + w0; *(f32x4*)o = v0; *(f32x4*)(o + 4) = v1; }
    }
    v4u uu[4][2];
#pragma unroll
    for (int m = 0; m < 4; ++m)
#pragma unroll
        for (int c2 = 0; c2 < 2; ++c2) uu[m][c2] = *(const v4u*)(Z + (size_t)(row0 + wr * 64 + m * 16 + fr) * 4096 + g * 256 + wc * 64 + c2 * 32 + fq * 8);
    LDS_BARRIER();
    f32x4 acc[4][4];
#pragma unroll
    for (int m = 0; m < 4; ++m)
#pragma unroll
        for (int n = 0; n < 4; ++n) acc[m][n] = (f32x4){0.f, 0.f, 0.f, 0.f};
    const int kend = wr * 64 + 64;
    for (int k0 = 0; k0 < kend; k0 += 32) {
        bf16x8 af[4], bfr[4];
#pragma unroll
        for (int m = 0; m < 4; ++m) af[m] = *(const LAS bf16x8*)(WsA + (wr * 64 + m * 16 + fr) * LP + k0 + fq * 8);
#pragma unroll
        for (int n = 0; n < 4; ++n) bfr[n] = tr_frag_pair(vT, VP, k0, wc * 2 + (n >> 1), n & 1, lane);
#pragma unroll
        for (int m = 0; m < 4; ++m)
#pragma unroll
            for (int n = 0; n < 4; ++n) acc[m][n] = MFMA16(bfr[n], af[m], acc[m][n]);
    }
    const float* b_s = a.in[14] + g * 128;
#pragma unroll
    for (int m = 0; m < 4; ++m) {
        const int t = wr * 64 + m * 16 + fr, row = row0 + t; const float bs = b_s[t];
#pragma unroll
        for (int c2 = 0; c2 < 2; ++c2) {
            const int col = g * 256 + wc * 64 + c2 * 32 + fq * 8;
            const v4u u = uu[m][c2]; const f32x4 a0 = acc[m][2 * c2], a1 = acc[m][2 * c2 + 1];
            v4u o;
            o.x = pk2(bf_lo(u.x) * (a0[0] + bs), bf_hi(u.x) * (a0[1] + bs)); o.y = pk2(bf_lo(u.y) * (a0[2] + bs), bf_hi(u.y) * (a0[3] + bs));
            o.z = pk2(bf_lo(u.z) * (a1[0] + bs), bf_hi(u.z) * (a1[1] + bs)); o.w = pk2(bf_lo(u.w) * (a1[2] + bs), bf_hi(u.w) * (a1[3] + bs));
            *(v4u*)(G + (size_t)row * DGM + col) = o;
        }
    }
    LDS_BARRIER();
}
__device__ __forceinline__ void gate_sample_unit(CArgs& a, int bsq, int tid) {
    const bf16* Z = (const bf16*)(a.ws + WS_BIG); bf16* G = (bf16*)(a.ws + WS_G); const float* stats = (const float*)(a.ws + WS_STATS);
    const int col = tid * 4, g = col >> 8, row0 = TP + bsq * 8;
    const f32x4 lg = *(const f32x4*)(a.in[11] + col), lb = *(const f32x4*)(a.in[12] + col);
    v2u raw[8], uu[8]; float s1[8], s2[8];
#pragma unroll
    for (int t = 0; t < 8; ++t) {
        const int row = row0 + t;
        raw[t] = *(const v2u*)(Z + (size_t)row * 4096 + 2048 + col); uu[t] = *(const v2u*)(Z + (size_t)row * 4096 + col);
        s1[t] = stats[2 * row]; s2[t] = stats[2 * row + 1];
    }
    f32x4 v[8];
#pragma unroll
    for (int t = 0; t < 8; ++t) {
        const float mu = s1[t] * (1.f / 2048.f), var = s2[t] * (1.f / 2048.f) - mu * mu, rstd = 1.0f / sqrtf(var + EPS);
        v[t][0] = (bf_lo(raw[t].x) - mu) * rstd * lg[0] + lb[0]; v[t][1] = (bf_hi(raw[t].x) - mu) * rstd * lg[1] + lb[1];
        v[t][2] = (bf_lo(raw[t].y) - mu) * rstd * lg[2] + lb[2]; v[t][3] = (bf_hi(raw[t].y) - mu) * rstd * lg[3] + lb[3];
        *(f32x4*)(a.out + O_VS + (size_t)(bsq * 8 + t) * 2048 + col) = v[t];
    }
    const float* w_s = a.in[13] + (size_t)g * 16384; const float* b_s = a.in[14] + g * 128;
#pragma unroll
    for (int t = 0; t < 8; ++t) {
        const int row = row0 + t; const float bs = b_s[t];
        f32x4 s = (f32x4){bs, bs, bs, bs};
#pragma unroll
        for (int q = 0; q < 8; ++q) if (q <= t) s += w_s[t * 128 + q] * v[q];
        const v2u u = uu[t];
        v2u o; o.x = pk2(bf_lo(u.x) * s[0], bf_hi(u.x) * s[1]); o.y = pk2(bf_lo(u.y) * s[2], bf_hi(u.y) * s[3]);
        *(v2u*)(G + (size_t)row * DGM + col) = o;
    }
}

constexpr int TPI = 144, XPI = 72;
constexpr int L_CM = 0, L_BM = 36864, L_BWT = 73728, L_XST = 110592, L_STB = 129024, L_ACUM = 146432, L_DTS = 146944, L_WS = 147456, L_EAC = 147968, L_CWP = 148480;
__device__ __forceinline__ void cv8(const v4u w, float (&r)[8]) {
    r[0] = bf_lo(w.x); r[1] = bf_hi(w.x); r[2] = bf_lo(w.y); r[3] = bf_hi(w.y); r[4] = bf_lo(w.z); r[5] = bf_hi(w.z); r[6] = bf_lo(w.w); r[7] = bf_hi(w.w);
}
__device__ __forceinline__ void ssd_prompt_unit(CArgs& a, ldsp lds, int b, int h, int tid) {
    const int g = h >> 2, wid = tid >> 6, lane = tid & 63, fr = lane & 15, fq = lane >> 4, wr = wid >> 2, wc = wid & 3;
    const bf16* ZX = (const bf16*)(a.ws + WS_BIG); bf16* G = (bf16*)(a.ws + WS_G); const float* DT = (const float*)(a.ws + WS_DT); float* SS = (float*)(a.ws + WS_SS);
    LAS bf16* CM = (LAS bf16*)(lds + L_CM); LAS bf16* BM = (LAS bf16*)(lds + L_BM); LAS bf16* BWT = (LAS bf16*)(lds + L_BWT);
    LAS bf16* XST = (LAS bf16*)(lds + L_XST); LAS bf16* STB = (LAS bf16*)(lds + L_STB);
    LAS float* ACUM = (LAS float*)(lds + L_ACUM); LAS float* DTS = (LAS float*)(lds + L_DTS); LAS float* WSV = (LAS float*)(lds + L_WS); LAS float* EAC = (LAS float*)(lds + L_EAC);
    const float A_h = -expf(a.in[20][h]), D_h = a.in[21][h], dtb = a.in[19][h];
    f32x4 st[4];
#pragma unroll
    for (int m = 0; m < 4; ++m) st[m] = (f32x4){0.f, 0.f, 0.f, 0.f};
    const int ck = tid % 40, tg = tid / 40, tb = tg * 11;
    int seg, ch0, cl;
    if (ck < 8) { seg = 0; cl = ck * 8; ch0 = h * 64 + cl; } else if (ck < 24) { seg = 1; cl = (ck - 8) * 8; ch0 = 2048 + g * 128 + cl; } else { seg = 2; cl = (ck - 24) * 8; ch0 = 3072 + g * 128 + cl; }
    LAS float* CWP = (LAS float*)(lds + L_CWP);
    {
        const float* conv_w = a.in[17]; const float* conv_b = a.in[18];
        for (int i = tid; i < 5 * 320; i += NTHR) { const int k = i / 320, cc = i % 320, ch = cc < 64 ? h * 64 + cc : (cc < 192 ? 2048 + g * 128 + (cc - 64) : 3072 + g * 128 + (cc - 192)); CWP[i] = k < 4 ? conv_w[k * 4096 + ch] : conv_b[ch]; }
    }
    const int ccl = (seg == 0 ? 0 : (seg == 1 ? 64 : 192)) + cl;
    v4u pf[14]; float dpf0 = 0.f, dpf1 = 0.f;
#define SSD_ISSUE(cn) do { const bf16* zp_ = ZX + (size_t)(b * 2048 + (cn) * 128) * ZXP + 2048 + ch0; \
        _Pragma("unroll") for (int i_ = 0; i_ < 14; ++i_) { const int rel_ = tb + i_ - 3; \
            if (rel_ < 128 && ((cn) > 0 || rel_ >= 0)) pf[i_] = *(const v4u*)(zp_ + (long)rel_ * ZXP); else pf[i_] = (v4u){0u, 0u, 0u, 0u}; } \
        } while (0)
#define SSD_DT(cn) do { if (wid == 0) { const float* dp_ = DT + (size_t)(b * 2048 + (cn) * 128 + 2 * lane) * 32 + h; dpf0 = dp_[0]; dpf1 = dp_[32]; } } while (0)
    SSD_DT(0);
    for (int c = 0; c < 16; ++c) {
        const int row0 = b * 2048 + c * 128;
        SSD_ISSUE(c);
        const float dr0 = dpf0, dr1 = dpf1;
        if (c < 15) SSD_DT(c + 1);
        const int trow = wid * 16 + fr;
        if (wid == 0) {
            const int t0 = 2 * lane;
            const float d0 = softplus_f(dr0 + dtb), d1 = softplus_f(dr1 + dtb);
            const float a0 = d0 * A_h, a1 = d1 * A_h, pr = a0 + a1; float inc = pr;
#pragma unroll
            for (int o = 1; o < 64; o <<= 1) { const float n = __shfl_up(inc, o); if (lane >= o) inc += n; }
            const float exc = inc - pr;
            ACUM[t0] = exc + a0; ACUM[t0 + 1] = inc; DTS[t0] = d0; DTS[t0 + 1] = d1;
        }
#pragma unroll
        for (int m = 0; m < 4; ++m) { v2u w; w.x = pk2(st[m][0], st[m][1]); w.y = pk2(st[m][2], st[m][3]); *(LAS v2u*)(STB + (m * 16 + fr) * LP + wid * 16 + fq * 4) = w; }
        LDS_BARRIER();
        const float aend = ACUM[127];
        {
            f32x2 cw0[4], cw1[4], cw2[4], cw3[4], cb[4];
#pragma unroll
            for (int j = 0; j < 4; ++j) { cw0[j] = *(const LAS f32x2*)(CWP + ccl + 2 * j); cw1[j] = *(const LAS f32x2*)(CWP + 320 + ccl + 2 * j); cw2[j] = *(const LAS f32x2*)(CWP + 640 + ccl + 2 * j);
                                          cw3[j] = *(const LAS f32x2*)(CWP + 960 + ccl + 2 * j); cb[j] = *(const LAS f32x2*)(CWP + 1280 + ccl + 2 * j); }
            LAS bf16* rbase = seg == 0 ? XST + tb * XPI + cl : (seg == 1 ? BM : CM) + tb * TPI + cl;
            LAS bf16* r2base = BWT + tb * TPI + cl;
            LAS float* wbase = DTS + tb; LAS float* abase = ACUM + tb;
            int nval = 128 - tb;
            asm volatile("" : "+v"(rbase), "+v"(r2base), "+v"(wbase), "+v"(abase), "+v"(nval));
            f32x2 rr[4][4];
#define CVP(W_, R_) do { R_[0] = (f32x2){bf_lo(W_.x), bf_hi(W_.x)}; R_[1] = (f32x2){bf_lo(W_.y), bf_hi(W_.y)}; R_[2] = (f32x2){bf_lo(W_.z), bf_hi(W_.z)}; R_[3] = (f32x2){bf_lo(W_.w), bf_hi(W_.w)}; } while (0)
            CVP(pf[0], rr[0]); CVP(pf[1], rr[1]); CVP(pf[2], rr[2]);
#pragma unroll
            for (int i = 0; i < 11; ++i) {
                CVP(pf[i + 3], rr[(i + 3) & 3]);
                if (i < nval) {
                    f32x2 v[4], x[4], e[4];
#pragma unroll
                    for (int j = 0; j < 4; ++j) x[j] = cb[j] + cw0[j] * rr[i & 3][j];
#pragma unroll
                    for (int j = 0; j < 4; ++j) x[j] = x[j] + cw1[j] * rr[(i + 1) & 3][j];
#pragma unroll
                    for (int j = 0; j < 4; ++j) x[j] = x[j] + cw2[j] * rr[(i + 2) & 3][j];
#pragma unroll
                    for (int j = 0; j < 4; ++j) x[j] = x[j] + cw3[j] * rr[(i + 3) & 3][j];
#pragma unroll
                    for (int j = 0; j < 4; ++j) e[j] = x[j] * (-1.4426950409f);
#pragma unroll
                    for (int j = 0; j < 4; ++j) { e[j].x = __builtin_amdgcn_exp2f(e[j].x); e[j].y = __builtin_amdgcn_exp2f(e[j].y); }
#pragma unroll
                    for (int j = 0; j < 4; ++j) e[j] = e[j] + 1.0f;
#pragma unroll
                    for (int j = 0; j < 4; ++j) { e[j].x = __builtin_amdgcn_rcpf(e[j].x); e[j].y = __builtin_amdgcn_rcpf(e[j].y); }
#pragma unroll
                    for (int j = 0; j < 4; ++j) v[j] = x[j] * e[j];
                    v4u w; w.x = pk2(v[0].x, v[0].y); w.y = pk2(v[1].x, v[1].y); w.z = pk2(v[2].x, v[2].y); w.w = pk2(v[3].x, v[3].y);
                    if (seg == 0) *(LAS v4u*)(rbase + i * XPI) = w;
                    else {
                        *(LAS v4u*)(rbase + i * TPI) = w;
                        if (seg == 1) {
                            const float wsv = wbase[i] * exp_f(aend - abase[i]);
                            const f32x2 a0 = v[0] * wsv, a1 = v[1] * wsv, a2 = v[2] * wsv, a3 = v[3] * wsv;
                            v4u w2; w2.x = pk2(a0.x, a0.y); w2.y = pk2(a1.x, a1.y); w2.z = pk2(a2.x, a2.y); w2.w = pk2(a3.x, a3.y);
                            *(LAS v4u*)(r2base + i * TPI) = w2;
                        }
                    }
                }
                __builtin_amdgcn_sched_barrier(0);
            }
#undef CVP
        }
        v2u zz[4];
#pragma unroll
        for (int n = 0; n < 4; ++n) zz[n] = *(const v2u*)(ZX + (size_t)(row0 + trow) * ZXP + h * 64 + n * 16 + fq * 4);
        unsigned pd0, pd1;
        {
            const int nrow0 = (c < 15 ? row0 + 128 : row0);
            const int li0 = tid, li1 = tid < 256 ? tid + 512 : tid;
            const int ra = li0 / 6, ka = li0 % 6, rb = li1 / 6, kb = li1 % 6;
            const int oa = ka == 0 ? h * 64 : (ka == 1 ? 2048 + h * 64 : (ka < 4 ? 4096 + g * 128 + (ka - 2) * 64 : 5120 + g * 128 + (ka - 4) * 64));
            const int ob = kb == 0 ? h * 64 : (kb == 1 ? 2048 + h * 64 : (kb < 4 ? 4096 + g * 128 + (kb - 2) * 64 : 5120 + g * 128 + (kb - 4) * 64));
            const bf16* pa = ZX + (size_t)(nrow0 + ra) * ZXP + oa; const bf16* pb = ZX + (size_t)(nrow0 + rb) * ZXP + ob;
            pd0 = *(const unsigned*)pa;
            pd1 = *(const unsigned*)pb;
        }
        LDS_BARRIER();
        {
            f32x4 cbv[4][2];
#pragma unroll
            for (int m = 0; m < 4; ++m)
#pragma unroll
                for (int n = 0; n < 2; ++n) cbv[m][n] = (f32x4){0.f, 0.f, 0.f, 0.f};
#pragma unroll
            for (int k0 = 0; k0 < 128; k0 += 32) {
                bf16x8 af[4], bfr[2];
#pragma unroll
                for (int m = 0; m < 4; ++m) af[m] = *(const LAS bf16x8*)(CM + (wr * 64 + m * 16 + fr) * TPI + k0 + fq * 8);
#pragma unroll
                for (int n = 0; n < 2; ++n) bfr[n] = *(const LAS bf16x8*)(BM + (wc * 32 + n * 16 + fr) * TPI + k0 + fq * 8);
#pragma unroll
                for (int m = 0; m < 4; ++m)
#pragma unroll
                    for (int n = 0; n < 2; ++n) cbv[m][n] = MFMA16(bfr[n], af[m], cbv[m][n]);
            }
            LDS_BARRIER();
#pragma unroll
            for (int m = 0; m < 4; ++m) {
                const int t = wr * 64 + m * 16 + fr; const float at = ACUM[t];
#pragma unroll
                for (int n = 0; n < 2; ++n) {
                    const int s0 = wc * 32 + n * 16 + fq * 4;
                    v2u w; w.x = 0u; w.y = 0u;
                    if (wc * 2 + n <= wr * 4 + m) {
                        float mv[4];
#pragma unroll
                        for (int j = 0; j < 4; ++j) { const int s = s0 + j; mv[j] = (s <= t) ? cbv[m][n][j] * exp_f(at - ACUM[s]) * DTS[s] : 0.f; }
                        w.x = pk2(mv[0], mv[1]); w.y = pk2(mv[2], mv[3]);
                    }
                    *(LAS v2u*)(BM + t * TPI + s0) = w;
                }
            }
            LDS_BARRIER();
        }
        {
            f32x4 yd[4], yo[4];
#pragma unroll
            for (int n = 0; n < 4; ++n) { yd[n] = (f32x4){0.f, 0.f, 0.f, 0.f}; yo[n] = (f32x4){0.f, 0.f, 0.f, 0.f}; }
#pragma unroll
            for (int k0 = 0; k0 < 128; k0 += 32) {
                if (k0 <= wid * 16 + 15) {
                    const bf16x8 am = *(const LAS bf16x8*)(BM + trow * TPI + k0 + fq * 8);
#pragma unroll
                    for (int n = 0; n < 4; ++n) { const bf16x8 bx = tr_frag(XST, XPI, k0, n, lane); yd[n] = MFMA16(bx, am, yd[n]); }
                }
                const bf16x8 ac = *(const LAS bf16x8*)(CM + trow * TPI + k0 + fq * 8);
#pragma unroll
                for (int n = 0; n < 4; ++n) { const bf16x8 bs = *(const LAS bf16x8*)(STB + (n * 16 + fr) * LP + k0 + fq * 8); yo[n] = MFMA16(bs, ac, yo[n]); }
            }
            const int row = row0 + trow; const float ea = exp_f(ACUM[trow]);
            float ssq = 0.f;
#pragma unroll
            for (int n = 0; n < 4; ++n) {
                const int p0 = n * 16 + fq * 4;
                const v2u xv = *(const LAS v2u*)(XST + trow * XPI + p0);
                const f32x2 z01 = (f32x2){bf_lo(zz[n].x), bf_hi(zz[n].x)}, z23 = (f32x2){bf_lo(zz[n].y), bf_hi(zz[n].y)};
                f32x2 y01 = (f32x2){yo[n][0], yo[n][1]} * ea, y23 = (f32x2){yo[n][2], yo[n][3]} * ea;
                f32x2 e01 = z01 * (-1.4426950409f), e23 = z23 * (-1.4426950409f);
                y01 = y01 + (f32x2){yd[n][0], yd[n][1]}; y23 = y23 + (f32x2){yd[n][2], yd[n][3]};
                e01.x = __builtin_amdgcn_exp2f(e01.x); e01.y = __builtin_amdgcn_exp2f(e01.y); e23.x = __builtin_amdgcn_exp2f(e23.x); e23.y = __builtin_amdgcn_exp2f(e23.y);
                y01 = y01 + (f32x2){bf_lo(xv.x), bf_hi(xv.x)} * D_h; y23 = y23 + (f32x2){bf_lo(xv.y), bf_hi(xv.y)} * D_h;
                e01 = e01 + 1.0f; e23 = e23 + 1.0f;
                e01.x = __builtin_amdgcn_rcpf(e01.x); e01.y = __builtin_amdgcn_rcpf(e01.y); e23.x = __builtin_amdgcn_rcpf(e23.x); e23.y = __builtin_amdgcn_rcpf(e23.y);
                e01 = e01 * z01; e23 = e23 * z23;
                y01 = y01 * e01; y23 = y23 * e23;
                const f32x2 q2 = y01 * y01 + y23 * y23;
                ssq += q2.x + q2.y;
                v2u w; w.x = pk2(y01.x, y01.y); w.y = pk2(y23.x, y23.y);
                *(v2u*)(G + (size_t)row * DIN + h * 64 + p0) = w;
            }
            ssq += __shfl_xor(ssq, 16); ssq += __shfl_xor(ssq, 32);
            if (fq == 0) SS[(size_t)row * 32 + h] = ssq;
        }
        {
            const float dec = exp_f(aend);
#pragma unroll
            for (int m = 0; m < 4; ++m) st[m] = st[m] * dec;
#pragma unroll
            for (int k0 = 0; k0 < 128; k0 += 32) {
                const bf16x8 bw = tr_frag(BWT, TPI, k0, wid, lane);
#pragma unroll
                for (int m = 0; m < 4; ++m) { const bf16x8 ax = tr_frag(XST, XPI, k0, m, lane); st[m] = MFMA16(bw, ax, st[m]); }
            }
        }
        asm volatile("" :: "v"(pd0), "v"(pd1));
        LDS_BARRIER();
    }
#undef SSD_ISSUE
#undef SSD_DT
    if (tid < 120) {
        const int r = tid / 40;
        float v[8]; cv8(*(const v4u*)(ZX + (size_t)(b * 2048 + 2045 + r) * ZXP + 2048 + ch0), v);
        float* o = a.out + O_CP + (size_t)(b * 3 + r) * 4096 + ch0;
        *(f32x4*)o = (f32x4){v[0], v[1], v[2], v[3]}; *(f32x4*)(o + 4) = (f32x4){v[4], v[5], v[6], v[7]};
    }
    float* so = a.out + O_SP + (size_t)(b * 32 + h) * 8192;
#pragma unroll
    for (int m = 0; m < 4; ++m) __builtin_nontemporal_store(st[m], (f32x4*)(so + (m * 16 + fr) * 128 + wid * 16 + fq * 4));
}

constexpr int S_RAW = 0, S_XS = 14080, S_BM = 16128, S_CM = 20224, S_DT = 24320, S_MM = 24416, S_YS = 24672, S_SLOT = 26752, S_CW = 2 * S_SLOT;
__device__ __forceinline__ int ssd_chan(int cc, int h, int g) { return cc < 64 ? h * 64 + cc : (cc < 192 ? 2048 + g * 128 + (cc - 64) : 3072 + g * 128 + (cc - 192)); }
__device__ __forceinline__ void ssd_sample_units(CArgs& a, ldsp lds, int bid, int G_, int tid) {
    const int lane = tid & 63, wid = tid >> 6;
    const bf16* ZX = (const bf16*)(a.ws + WS_BIG); bf16* G = (bf16*)(a.ws + WS_G); const float* DT = (const float*)(a.ws + WS_DT); float* SS = (float*)(a.ws + WS_SS);
    LAS float* CW = (LAS float*)(lds + S_CW);
    const float* sconv = a.in[5];
    const int p = tid >> 3, q = tid & 7, n0 = q * 16;
    int hc = -1;
    float A_h = 0.f, D_h = 0.f, dtb = 0.f;
    f32x4 s0[2][4]; float cv0[2] = {0.f, 0.f}, cv1[2] = {0.f, 0.f}; unsigned short zb[2][7] = {{0, 0, 0, 0, 0, 0, 0}, {0, 0, 0, 0, 0, 0, 0}}; float dtv[2] = {0.f, 0.f}; unsigned short zvb[2] = {0, 0};
#define SMP_ISSUE(j_, u_) do { const int bs_ = (u_) >> 5, h_ = (u_) & 31, g_ = h_ >> 2, r0_ = TP + bs_ * 8; \
        const float* sp_ = a.in[4] + ((size_t)(bs_ * 32 + h_) * 64 + p) * 128 + n0; \
        _Pragma("unroll") for (int i_ = 0; i_ < 4; ++i_) s0[j_][i_] = *(const f32x4*)(sp_ + 4 * i_); \
        { const int e_ = tid; cv0[j_] = sconv[(size_t)(bs_ * 3 + e_ / 320) * 4096 + ssd_chan(e_ % 320, h_, g_)]; } \
        { const int e_ = tid + NTHR, rr_ = e_ / 320, ch_ = ssd_chan(e_ % 320, h_, g_); \
          if (e_ < 960) cv1[j_] = sconv[(size_t)(bs_ * 3 + rr_) * 4096 + ch_]; else zb[j_][1] = ZX[(size_t)(r0_ + rr_ - 3) * ZXP + 2048 + ch_]; } \
        _Pragma("unroll") for (int i_ = 2; i_ < 7; ++i_) { const int e_ = tid + i_ * NTHR; \
            if (e_ < 11 * 320) zb[j_][i_] = ZX[(size_t)(r0_ + e_ / 320 - 3) * ZXP + 2048 + ssd_chan(e_ % 320, h_, g_)]; } \
        if (tid < 8) dtv[j_] = DT[(size_t)(r0_ + tid) * 32 + h_]; \
        zvb[j_] = ZX[(size_t)(r0_ + q) * ZXP + h_ * 64 + p]; } while (0)
    int u = bid;
    if (u < 4096) { SMP_ISSUE(0, u); if (u + G_ < 4096) SMP_ISSUE(1, u + G_); }
    for (; u < 4096; u += 2 * G_) {
        const int nu = (u + G_ < 4096) ? 2 : 1;
        const int h = u & 31, g = h >> 2;
        const int h1 = (u + G_) & 31;
        if (h != hc || (nu == 2 && h1 != h)) {
            LDS_BARRIER();
            A_h = -expf(a.in[20][h]); D_h = a.in[21][h]; dtb = a.in[19][h];
            const float* conv_w = a.in[17]; const float* conv_b = a.in[18];
            for (int i = tid; i < 5 * 320; i += NTHR) { const int k = i / 320, cc = i % 320, ch = ssd_chan(cc, h, g); CW[i] = k < 4 ? conv_w[k * 4096 + ch] : conv_b[ch]; }
            hc = h;
        }
        float rv[2][7]; f32x4 sc[2][4]; float zc[2];
#pragma unroll
        for (int j = 0; j < 2; ++j) {
            LAS float* RAW = (LAS float*)(lds + j * S_SLOT + S_RAW); LAS float* DTs = (LAS float*)(lds + j * S_SLOT + S_DT);
#pragma unroll
            for (int i = 0; i < 7; ++i) { const int e = tid + i * NTHR; rv[j][i] = i == 0 ? cv0[j] : (i == 1 && e < 960 ? cv1[j] : bf1(zb[j][i])); }
#pragma unroll
            for (int i = 0; i < 7; ++i) { const int e = tid + i * NTHR; if (e < 11 * 320) RAW[e] = rv[j][i]; }
            if (tid < 8) DTs[tid] = softplus_f(dtv[j] + dtb);
#pragma unroll
            for (int i = 0; i < 4; ++i) sc[j][i] = s0[j][i];
            zc[j] = bf1(zvb[j]);
        }
        LDS_BARRIER();
        if (u + 2 * G_ < 4096) { SMP_ISSUE(0, u + 2 * G_); if (u + 3 * G_ < 4096) SMP_ISSUE(1, u + 3 * G_); }
        float dts[2][8], acs[2][8];
#pragma unroll
        for (int j = 0; j < 2; ++j) {
            LAS float* DTs = (LAS float*)(lds + j * S_SLOT + S_DT);
            float ac = 0.f;
#pragma unroll
            for (int t = 0; t < 8; ++t) { dts[j][t] = DTs[t]; ac += dts[j][t] * A_h; acs[j][t] = ac; }
        }
#pragma unroll
        for (int j = 0; j < 2; ++j) {
            LAS float* RAW = (LAS float*)(lds + j * S_SLOT + S_RAW); LAS float* XS = (LAS float*)(lds + j * S_SLOT + S_XS); LAS float* BMs = (LAS float*)(lds + j * S_SLOT + S_BM); LAS float* CMs = (LAS float*)(lds + j * S_SLOT + S_CM);
#pragma unroll
            for (int i = 0; i < 5; ++i) {
                const int e = tid + i * NTHR, t = e / 320, cc = e % 320;
                float v = CW[4 * 320 + cc];
#pragma unroll
                for (int k = 0; k < 4; ++k) v += RAW[(t + k) * 320 + cc] * CW[k * 320 + cc];
                v = silu_f(v);
                if (cc < 64) XS[t * 64 + cc] = v; else if (cc < 192) BMs[t * 128 + cc - 64] = v; else CMs[t * 128 + cc - 192] = v;
            }
        }
        LDS_BARRIER();
#pragma unroll
        for (int j = 0; j < 2; ++j) if (j < nu) {
            const int uu = u + j * G_, bsq = uu >> 5;
            LAS float* XS = (LAS float*)(lds + j * S_SLOT + S_XS); LAS float* BMs = (LAS float*)(lds + j * S_SLOT + S_BM); LAS float* CMs = (LAS float*)(lds + j * S_SLOT + S_CM); LAS float* MM = (LAS float*)(lds + j * S_SLOT + S_MM);
            const float aend = acs[j][7];
#pragma unroll
            for (int i = 5; i < 7; ++i) { const int e = tid + i * NTHR; if (e >= 8 * 320 && e < 11 * 320) a.out[O_CSS + (size_t)(bsq * 3 + e / 320 - 8) * 4096 + ssd_chan(e % 320, h, g)] = rv[j][i]; }
            {
                const float dec = exp_f(aend);
                f32x4 ns[4];
#pragma unroll
                for (int i = 0; i < 4; ++i) ns[i] = sc[j][i] * dec;
#pragma unroll
                for (int s = 0; s < 8; ++s) {
                    const float xw = XS[s * 64 + p] * dts[j][s] * exp_f(aend - acs[j][s]);
#pragma unroll
                    for (int i = 0; i < 4; ++i) { const f32x4 bv = *(const LAS f32x4*)(BMs + s * 128 + n0 + 4 * i); ns[i] += xw * bv; }
                }
                float* so = a.out + O_SSS + ((size_t)(bsq * 32 + h) * 64 + p) * 128 + n0;
#pragma unroll
                for (int i = 0; i < 4; ++i) __builtin_nontemporal_store(ns[i], (f32x4*)(so + 4 * i));
            }
            {
                const int pr = tid >> 3, t = pr >> 3, s = pr & 7;
                float cbv = 0.f;
#pragma unroll
                for (int i = 0; i < 4; ++i) { const f32x4 cv = *(const LAS f32x4*)(CMs + t * 128 + n0 + 4 * i), bv = *(const LAS f32x4*)(BMs + s * 128 + n0 + 4 * i); cbv += (cv[0] * bv[0] + cv[1] * bv[1]) + (cv[2] * bv[2] + cv[3] * bv[3]); }
                cbv += __shfl_xor(cbv, 1); cbv += __shfl_xor(cbv, 2); cbv += __shfl_xor(cbv, 4);
                float at = 0.f, as = 0.f, ds = 0.f;
#pragma unroll
                for (int k = 0; k < 8; ++k) { at = (t == k) ? acs[j][k] : at; as = (s == k) ? acs[j][k] : as; ds = (s == k) ? dts[j][k] : ds; }
                if (q == 0) MM[pr] = (s <= t) ? cbv * exp_f(at - as) * ds : 0.f;
            }
        }
        LDS_BARRIER();
#pragma unroll
        for (int j = 0; j < 2; ++j) if (j < nu) {
            LAS float* XS = (LAS float*)(lds + j * S_SLOT + S_XS); LAS float* CMs = (LAS float*)(lds + j * S_SLOT + S_CM); LAS float* MM = (LAS float*)(lds + j * S_SLOT + S_MM); LAS float* YS = (LAS float*)(lds + j * S_SLOT + S_YS);
            float mine = 0.f;
#pragma unroll
            for (int t = 0; t < 8; ++t) {
                float pt = 0.f;
#pragma unroll
                for (int i = 0; i < 4; ++i) { const f32x4 cv = *(const LAS f32x4*)(CMs + t * 128 + n0 + 4 * i); pt += (cv[0] * sc[j][i][0] + cv[1] * sc[j][i][1]) + (cv[2] * sc[j][i][2] + cv[3] * sc[j][i][3]); }
                pt += __shfl_xor(pt, 1); pt += __shfl_xor(pt, 2); pt += __shfl_xor(pt, 4);
                mine = (q == t) ? pt : mine;
            }
            float aq = 0.f;
#pragma unroll
            for (int k = 0; k < 8; ++k) aq = (q == k) ? acs[j][k] : aq;
            float y = exp_f(aq) * mine + D_h * XS[q * 64 + p];
#pragma unroll
            for (int s = 0; s < 8; ++s) y += MM[q * 8 + s] * XS[s * 64 + p];
            YS[q * 64 + p] = y * silu_f(zc[j]);
        }
        LDS_BARRIER();
#pragma unroll
        for (int j = 0; j < 2; ++j) if (j < nu) {
            const int uu = u + j * G_, row0 = TP + (uu >> 5) * 8;
            LAS float* YS = (LAS float*)(lds + j * S_SLOT + S_YS);
            const int t = wid; const float y = YS[t * 64 + lane];
            G[(size_t)(row0 + t) * DIN + h * 64 + lane] = (bf16)f2bf(y);
            const float ssq = wave_sum(y * y);
            if (lane == 0) SS[(size_t)(row0 + t) * 32 + h] = ssq;
        }
    }
#undef SMP_ISSUE
    LDS_BARRIER();
}
#define XB_TMO      128
#define XB_XCNT(j)  (256  + 64 * (j))
#define XB_XSUB(j)  (1280 + 64 * (j))
#define XB_XGEN(j)  (2304 + 64 * (j))
#define XB_TOP      3328
#define XB_TOPGEN   3392
#define XCD_BAR_WORDS 3456
#define XB_SPIN_CAP (1u << 18)

__device__ __forceinline__ unsigned xb_ld(unsigned* p)              { return __hip_atomic_load(p, __ATOMIC_RELAXED, __HIP_MEMORY_SCOPE_AGENT); }
__device__ __forceinline__ unsigned xb_add(unsigned* p, unsigned v) { return __hip_atomic_fetch_add(p, v, __ATOMIC_RELAXED, __HIP_MEMORY_SCOPE_AGENT); }
__device__ __forceinline__ unsigned xb_xcc_id() { return (unsigned)__builtin_amdgcn_s_getreg((3 << 11) | 20) & 0xFu; }
#define XB_SPIN(cond, bar) do { unsigned _sp = 0; while (cond) { __builtin_amdgcn_s_sleep(1); \
    if ((++_sp & 255u) == 0u) { if (xb_ld(&(bar)[XB_TMO])) break; if (_sp > XB_SPIN_CAP) { atomicAdd(&(bar)[XB_TMO], 1u); break; } } } } while (0)

struct XcdBarrier {
    unsigned* bar; unsigned x;
    volatile LAS unsigned* st;
};

__device__ __forceinline__ XcdBarrier xcd_barrier_post(unsigned* bar, volatile LAS unsigned* st) {
    XcdBarrier b; b.bar = bar; b.x = xb_xcc_id(); b.st = st;
    if (threadIdx.x == 0) (void)xb_add(&bar[XB_XCNT(b.x)], 1u);
    return b;
}
__device__ __forceinline__ void xcd_barrier_complete(unsigned* bar, unsigned x, unsigned& nloc, unsigned& nx) {
    const unsigned G = gridDim.x * gridDim.y * gridDim.z;
    unsigned sum, cnt, mine, sp = 0u;
    for (;;) {
        sum = 0u; cnt = 0u; mine = 0u;
#pragma unroll
        for (unsigned j = 0; j < 16; ++j) { const unsigned c = xb_ld(&bar[XB_XCNT(j)]); sum += c; cnt += (c > 0u) ? 1u : 0u; mine = (j == x) ? c : mine; }
        if (sum == G) break;
        __builtin_amdgcn_s_sleep(1);
        if ((++sp & 255u) == 0u) { if (xb_ld(&bar[XB_TMO])) break; if (sp > XB_SPIN_CAP) { atomicAdd(&bar[XB_TMO], 1u); break; } }
    }
    nloc = mine > 0u ? mine : 1u; nx = cnt > 0u ? cnt : 1u;
}

__device__ __forceinline__ void xcd_barrier(const XcdBarrier& b) {
    asm volatile("s_waitcnt vmcnt(0)" ::: "memory");
    __syncthreads();
    if (threadIdx.x == 0) {
        unsigned* bar = b.bar;
        __builtin_amdgcn_s_waitcnt(0);
        unsigned nloc = b.st[0], nx = b.st[1];
        if (nloc == 0u) { xcd_barrier_complete(bar, b.x, nloc, nx); b.st[0] = nloc; b.st[1] = nx; }
        const unsigned old = xb_add(&bar[XB_XSUB(b.x)], 1u);
        const unsigned gen = old / nloc;
        if (old + 1u == (gen + 1u) * nloc) {
            __builtin_amdgcn_fence(__ATOMIC_RELEASE, "agent");
            asm volatile("s_waitcnt vmcnt(0)" ::: "memory");
            const unsigned og = xb_add(&bar[XB_TOP], 1u);
            const unsigned tg = og / nx;
            if (og + 1u == (tg + 1u) * nx) xb_add(&bar[XB_TOPGEN], 1u);
            else XB_SPIN(xb_ld(&bar[XB_TOPGEN]) == tg, bar);
            __builtin_amdgcn_fence(__ATOMIC_ACQUIRE, "agent");
            xb_add(&bar[XB_XGEN(b.x)], 1u);
            asm volatile("s_waitcnt vmcnt(0)" ::: "memory");
        } else {
            XB_SPIN(xb_ld(&bar[XB_XGEN(b.x)]) == gen, bar);
            __builtin_amdgcn_fence(__ATOMIC_ACQUIRE, "agent");
            asm volatile("s_waitcnt vmcnt(0)" ::: "memory");
        }
    }
    __syncthreads();
}

#ifndef PROBE
#define PROBE -1
#endif
#if PROBE == 12
#define PROBE12_EXTRA { int tid3 = threadIdx.x; asm volatile("" : "+v"(tid3)); ssd_sample_units(a, lds, bid, G_, tid3); }
#else
#define PROBE12_EXTRA
#endif
constexpr int NPH = 18;
__global__ void __launch_bounds__(NTHR, 2) mk_fwd(Args a_) {
    extern __shared__ __attribute__((aligned(16))) unsigned char lds_raw[];
    cg::grid_group grid = cg::this_grid();
    ldsp lds = (ldsp)lds_raw;
    const int ph_lo = a_.ph_lo, ph_hi = a_.ph_hi;
    volatile LAS unsigned* MISC = (volatile LAS unsigned*)(lds + MISC_OFF);
    if (threadIdx.x < 16) MISC[threadIdx.x] = 0u;
    __syncthreads();
    (void)xcd_barrier_post((unsigned*)(a_.ws + WS_CTL), MISC + 8);
#define PH_BEGIN(k) if (ph_lo <= (k) && (k) < ph_hi) { \
        CArgs* ap = (CArgs*)__builtin_amdgcn_kernarg_segment_ptr(); asm volatile("" : "+s"(ap)); CArgs& a = *ap; \
        int tid = threadIdx.x; asm volatile("" : "+v"(tid)); int G_ = gridDim.x, bid = blockIdx.x; asm volatile("" : "+s"(G_), "+s"(bid)); \
        const int lane = tid & 63, wave = __builtin_amdgcn_readfirstlane(tid >> 6), gw = bid * NWAVES + wave, NGW = G_ * NWAVES; (void)lane; (void)gw; (void)NGW; \
        unsigned char* ws = a.ws; float* XR = a.out + O_Y; const float* MOD = (const float*)(ws + WS_MOD); (void)XR; (void)MOD; \
        bf16* H = (bf16*)(ws + WS_H); bf16* BIG = (bf16*)(ws + WS_BIG); bf16* GB = (bf16*)(ws + WS_G); (void)H; (void)BIG; (void)GB;
#define PH_END(k) if ((k) + 1 < ph_hi) { if (ph_hi > 1000) grid.sync(); else { XcdBarrier bar; bar.bar = (unsigned*)(ws + WS_CTL); bar.x = xb_xcc_id(); bar.st = (volatile LAS unsigned*)(lds + MISC_OFF) + 8; xcd_barrier(bar); } } }
#define RUN_GEMM() do { pg8::StaticOrder S; S.init(gm.M, gm.N, G_, bid); pg8::gemm_phase<pg8::EpiGen, pg8::StaticOrder, true, true>(lds, gm, S, E); } while (0)
#define EPI0 pg8::EpiGen E{0, 0, nullptr, 0, nullptr, nullptr, nullptr}
#define RUN_RES_GEMM(Aptr, Wptr, KK, GATE, MODE1, BASE) do { \
        { pg8::Gemm gm{(Aptr), (Wptr), TP, 1024, (KK), (KK)}; EPI0; E.mode = (MODE1); E.F = XR; E.aux = (GATE); E.aux2 = const_cast<float*>(BASE); pg8::StaticOrder S; S.init(TP, 1024, G_, bid, 0, 1); pg8::gemm_phase<pg8::EpiGen, pg8::StaticOrder, true, true>(lds, gm, S, E); } \
        { pg8::Gemm gm{(Aptr), (Wptr), TS, 1024, (KK) / NSPLIT, (KK)}; EPI0; E.mode = 3; E.F = (float*)(ws + WS_PART); E.aux = (GATE); pg8::StaticOrder S; S.init(TS, 1024, G_, bid, TP / 256, NSPLIT); pg8::gemm_phase<pg8::EpiGen, pg8::StaticOrder, true, true>(lds, gm, S, E); } } while (0)

    PH_BEGIN(0) p0_prologue(a, lds, 0, 2 * I_ADA, gw, NGW, true, wave, lane); PH_END(0)
    PH_BEGIN(1) { pg8::Gemm gm{(const bf16*)(ws + WS_CS), (const bf16*)(ws + WS_WADA), 256, NMODC, 1024, 1024}; EPI0; E.mode = 2; E.F = (float*)(ws + WS_MOD); E.aux = a.in[7]; RUN_GEMM(); }
                { const int nb_ = (NMODC / 256) < G_ ? (NMODC / 256) : 0; if (bid >= nb_) p0_prologue(a, lds, 2 * I_ADA, NITEMS, gw - nb_ * NWAVES, NGW - nb_ * NWAVES, false, wave, lane); } PH_END(1)
    PH_BEGIN(2) normmod_phase(a.in[0], a.in[1], a.in[8], MOD + 0, MOD + 1024, H, XR, nullptr, gw, NGW, lane); PH_END(2)
    PH_BEGIN(3) { pg8::Gemm gm{H, (const bf16*)(ws + WS_WGIN), T, 4096, 1024, 1024}; EPI0; E.mode = 16; E.act = 1; E.O = BIG; E.ldc = 4096; E.aux2 = (float*)(ws + WS_STATS); RUN_GEMM(); } PH_END(3)
    PH_BEGIN(4) for (int rep = 0; rep < (PROBE == 4 ? 2 : 1); ++rep) for (int u = bid; u < 1024 + 128; u += G_) { if (u < 1024) gate_prompt_unit(a, lds, u, tid); else gate_sample_unit(a, u - 1024, tid); } PH_END(4)
    PH_BEGIN(5) RUN_RES_GEMM(GB, (const bf16*)(ws + WS_WGOUT), 2048, MOD + 2048, 5, a.in[0]); PH_END(5)
    PH_BEGIN(6) normmod_phase(XR, XR + (size_t)TP * D, a.in[9], MOD + 3072, MOD + 4096, H, nullptr, (const float*)(ws + WS_PART), gw, NGW, lane); PH_END(6)
    PH_BEGIN(7) { pg8::Gemm gm{H, (const bf16*)(ws + WS_WM1), T, 4096, 1024, 1024}; EPI0; E.mode = 0; E.act = 2; E.O = BIG; E.ldc = 4096; for (int rep = 0; rep < (PROBE == 7 ? 2 : 1); ++rep) RUN_GEMM(); } PH_END(7)
    PH_BEGIN(8) RUN_RES_GEMM(BIG, (const bf16*)(ws + WS_WM2), 4096, MOD + 5120, 1, (const float*)nullptr); PH_END(8)
    PH_BEGIN(9) normmod_phase(XR, XR + (size_t)TP * D, a.in[8] + 1024, MOD + 6144, MOD + 6144 + 1024, H, nullptr, (const float*)(ws + WS_PART), gw, NGW, lane); PH_END(9)
    PH_BEGIN(10) { pg8::Gemm gm{H, (const bf16*)(ws + WS_WSIN), T, NPROJ_PAD, 1024, 1024}; EPI0; E.mode = 32; E.act = 0; E.O = BIG; E.ldc = ZXP; E.aux2 = (float*)(ws + WS_DT); RUN_GEMM(); } PH_END(10)
    PH_BEGIN(11) { for (int u = bid; u < 256; u += G_) { const int xg = u & 7, sl = u >> 3; ssd_prompt_unit(a, lds, sl >> 2, xg * 4 + (sl & 3), tid); }     int tid2 = threadIdx.x; asm volatile("" : "+v"(tid2)); ssd_sample_units(a, lds, bid, G_, tid2); PROBE12_EXTRA } PH_END(11)
    PH_BEGIN(12) groupnorm_phase(GB, (const float*)(ws + WS_SS), gw, NGW, lane); PH_END(12)
    PH_BEGIN(13) RUN_RES_GEMM(GB, (const bf16*)(ws + WS_WSOUT), 2048, MOD + 6144 + 2048, 1, (const float*)nullptr); PH_END(13)
    PH_BEGIN(14) normmod_phase(XR, XR + (size_t)TP * D, a.in[9] + 1024, MOD + 6144 + 3072, MOD + 6144 + 4096, H, nullptr, (const float*)(ws + WS_PART), gw, NGW, lane); PH_END(14)
    PH_BEGIN(15) { pg8::Gemm gm{H, (const bf16*)(ws + WS_WM1) + (size_t)4096 * 1024, T, 4096, 1024, 1024}; EPI0; E.mode = 0; E.act = 2; E.O = BIG; E.ldc = 4096; RUN_GEMM(); } PH_END(15)
    PH_BEGIN(16) RUN_RES_GEMM(BIG, (const bf16*)(ws + WS_WM2) + (size_t)1024 * 4096, 4096, MOD + 6144 + 5120, 1, (const float*)nullptr); PH_END(16)
    PH_BEGIN(17) finalnorm_phase(XR, a.in[26], (const float*)(ws + WS_PART), gw, NGW, lane); PH_END(17)
}

#ifndef MK_PER_PHASE
#define MK_PER_PHASE 0
#endif
extern "C" void kernel_launch(void* const* d_in, const int* in_sizes, int n_in, void* d_out, int out_size, void* d_ws, size_t ws_size, hipStream_t stream) {
    static int grid = 0;
    if (grid == 0) {
        if (n_in != 27 || (size_t)out_size != O_END || ws_size < WS_END) { fprintf(stderr, "kernel_launch: unexpected shapes: n_in %d out %d ws %zu (need %zu)\n", n_in, out_size, ws_size, (size_t)WS_END); grid = -1; return; }
        int dev = 0, cus = 0, per_cu = 0;
        if (hipGetDevice(&dev) != hipSuccess || hipDeviceGetAttribute(&cus, hipDeviceAttributeMultiprocessorCount, dev) != hipSuccess) { grid = -1; return; }
        if (hipFuncSetAttribute((const void*)mk_fwd, hipFuncAttributeMaxDynamicSharedMemorySize, LDS_BYTES) != hipSuccess) { fprintf(stderr, "kernel_launch: hipFuncSetAttribute failed\n"); grid = -1; return; }
        if (hipOccupancyMaxActiveBlocksPerMultiprocessor(&per_cu, (const void*)mk_fwd, NTHR, LDS_BYTES) != hipSuccess || per_cu < 1) { fprintf(stderr, "kernel_launch: occupancy query says %d\n", per_cu); per_cu = 1; }
        (void)hipGetLastError();
        grid = cus * 1;
    }
    if (grid < 0) return;
    if (hipMemsetAsync((char*)d_ws + WS_CTL, 0, CTL_BYTES, stream) != hipSuccess) { fprintf(stderr, "kernel_launch: memset of the control words failed\n"); return; }
    Args a{};
    for (int i = 0; i < 27; ++i) a.in[i] = (const float*)d_in[i];
    a.out = (float*)d_out; a.ws = (unsigned char*)d_ws;
#if MK_PER_PHASE
    for (int ph = 0; ph < NPH; ++ph) {
        a.ph_lo = ph; a.ph_hi = ph + 1;
        hipLaunchKernelGGL(mk_fwd, dim3(grid), dim3(NTHR), LDS_BYTES, stream, a);
    }
#else
    a.ph_lo = 0; a.ph_hi = NPH;
    void* args[] = {&a};
    hipError_t e = hipLaunchCooperativeKernel((const void*)mk_fwd, dim3(grid), dim3(NTHR), args, LDS_BYTES, stream);
    if (e != hipSuccess) fprintf(stderr, "kernel_launch: cooperative launch failed: %s (grid %d)\n", hipGetErrorString(e), grid);
#endif
}
```

```cpp
#include <hip/hip_runtime.h>
#include <hip/hip_cooperative_groups.h>
#include <cstdio>
#include <cstdint>
namespace cg = cooperative_groups;
namespace pg8 {
#define PG8_LAS __attribute__((address_space(3)))
typedef unsigned short bf16_t;
typedef short bf16x8 __attribute__((ext_vector_type(8)));
typedef float f32x4 __attribute__((ext_vector_type(4)));
typedef unsigned u32x4 __attribute__((ext_vector_type(4)));
constexpr int BM = 256, BK = 64, HALF = 128, HTB = HALF * BK * 2  , STAGE_BYTES = 8 * HTB, NXCD = 8, WGM = 8;

__host__ __device__ __forceinline__ int lds_byte(int r, int c) { const int st = (r >> 4) * 2 + (c >> 5), rr = r & 15, cc = c & 31, ob = rr * 64 + cc * 2; return st * 1024 + (ob ^ (((ob >> 9) & 1) << 5)); }
__host__ __device__ __forceinline__ void stage_rc(int b, int& R, int& C) { const int st = b / 1024, sb = b % 1024, swz = sb ^ (((sb >> 9) & 1) << 5); R = (st >> 1) * 16 + swz / 64; C = (st & 1) * 32 + (swz % 64) / 2; }
__host__ __device__ __forceinline__ int perm32(int rho) { const int n = rho >> 4, i = rho & 15; return 8 * (i >> 2) + 4 * n + (i & 3); }

struct Unit { int pm, pn, ks; };
struct Gemm { const bf16_t* A; const bf16_t* Bt; int M, N, K, ld; };

struct StaticOrder {
    int nM, nN, nwg, G, c, pm0, nsplit;
    __host__ __device__ void init(int M, int N, int G_, int c_, int pm0_ = 0, int nsplit_ = 1) { nM = M / BM; nN = N / BM; nwg = nM * nN; G = G_; c = c_; pm0 = pm0_; nsplit = nsplit_; }
    __host__ __device__ bool next(int i, Unit& u) const {
        const long L = (long)i * G + c; if (L >= (long)nwg * nsplit) return false;
        if (nsplit > 1) { const int ti = (int)L % nwg; u.ks = (int)L / nwg; u.pm = pm0 + ti % nM; u.pn = ti / nM; return true; }
        int wgid = (int)L; { const int q = nwg / NXCD, r = nwg % NXCD, xcd = wgid % NXCD, off = wgid / NXCD; wgid = (xcd < r ? xcd * (q + 1) : r * (q + 1) + (xcd - r) * q) + off; }
        const int nig = WGM * nN, gid = wgid / nig, fm = gid * WGM, gsz = (nM - fm) < WGM ? (nM - fm) : WGM;
        u.pm = pm0 + fm + ((wgid % nig) % gsz); u.pn = (wgid % nig) / gsz; u.ks = 0; return true;
    }
    __device__ __forceinline__ void a_ready(const Unit&) const {}
    __device__ __forceinline__ void done(const Unit&) const {}
};
__device__ __forceinline__ unsigned cvt_pk_bf16(float lo, float hi) { unsigned r; asm volatile("v_cvt_pk_bf16_f32 %0, %1, %2" : "=v"(r) : "v"(lo), "v"(hi)); return r; }
typedef float f32x2 __attribute__((ext_vector_type(2)));
constexpr int EPI_TP = 16384;
__device__ __forceinline__ void act_gelu_tanh8(f32x2 (&x)[4]) {
    f32x2 t[4];
#pragma unroll
    for (int j = 0; j < 4; ++j) t[j] = x[j] * x[j];
#pragma unroll
    for (int j = 0; j < 4; ++j) t[j] = t[j] * (-2.3022082f * 0.044715f) + (-2.3022082f);
#pragma unroll
    for (int j = 0; j < 4; ++j) t[j] = t[j] * x[j];
#pragma unroll
    for (int j = 0; j < 4; ++j) { t[j].x = __builtin_amdgcn_exp2f(t[j].x); t[j].y = __builtin_amdgcn_exp2f(t[j].y); }
#pragma unroll
    for (int j = 0; j < 4; ++j) t[j] = t[j] + 1.0f;
#pragma unroll
    for (int j = 0; j < 4; ++j) { t[j].x = __builtin_amdgcn_rcpf(t[j].x); t[j].y = __builtin_amdgcn_rcpf(t[j].y); }
#pragma unroll
    for (int j = 0; j < 4; ++j) x[j] = x[j] * t[j];
}
struct EpiGen {
    static constexpr bool PERM = true, AFTER_DRAIN = false;
    int mode;
    int act;
    bf16_t* O; int ldc;
    float* F;
    const float* aux;
    float* aux2;
    __device__ __forceinline__ void operator()(const f32x4 (&acc)[2][2][4][2], const Unit& u, int wr, int wc, int fr, int fq) const {
        const int row0 = u.pm * BM + wr * 64 + fr;
        const int col0 = u.pn * BM + wc * 32 + 8 * fq;
        const int md = mode & 15;
        if (md == 0) {
            const bool dtt = (mode & 32) && (u.pn == 24);
            const bool st = (mode & 16) && (u.pn >= 8);
#pragma unroll
            for (int ai = 0; ai < 2; ++ai)
#pragma unroll
                for (int m = 0; m < 4; ++m) {
                    const int row = row0 + ai * HALF + m * 16;
                    float s = 0.f, q = 0.f;
#pragma unroll
                    for (int bj = 0; bj < 2; ++bj) {
                        f32x4 v0 = acc[ai][bj][m][0], v1 = acc[ai][bj][m][1];
                        if (act == 1) {
                            { f32x2 p[4] = {(f32x2){v0[0], v0[1]}, (f32x2){v0[2], v0[3]}, (f32x2){v1[0], v1[1]}, (f32x2){v1[2], v1[3]}}; act_gelu_tanh8(p);
                              v0 = (f32x4){p[0].x, p[0].y, p[1].x, p[1].y}; v1 = (f32x4){p[2].x, p[2].y, p[3].x, p[3].y}; }
                        } else if (act == 2) {
#pragma unroll
                            for (int e = 0; e < 4; ++e) { const float a = v0[e] > 0.f ? v0[e] : 0.f, b = v1[e] > 0.f ? v1[e] : 0.f; v0[e] = a * a; v1[e] = b * b; }
                        }
                        if (dtt) {
                            if (bj == 0 && wc == 0) { float* d = aux2 + (size_t)row * 32 + 8 * fq; *(f32x4*)d = v0; *(f32x4*)(d + 4) = v1; }
                        } else {
                            u32x4 w; w.x = cvt_pk_bf16(v0[0], v0[1]); w.y = cvt_pk_bf16(v0[2], v0[3]); w.z = cvt_pk_bf16(v1[0], v1[1]); w.w = cvt_pk_bf16(v1[2], v1[3]);
                            *(u32x4*)(O + (size_t)row * ldc + col0 + bj * HALF) = w;
                        }
                        if (st) {
#pragma unroll
                            for (int e = 0; e < 4; ++e) { s += v0[e] + v1[e]; q += v0[e] * v0[e] + v1[e] * v1[e]; }
                        }
                    }
                    if (st) {
                        s += __shfl_xor(s, 16); s += __shfl_xor(s, 32); q += __shfl_xor(q, 16); q += __shfl_xor(q, 32);
                        if (fq == 0) { atomicAdd(aux2 + 2 * (size_t)row, s); atomicAdd(aux2 + 2 * (size_t)row + 1, q); }
                    }
                }
        } else if (md == 1 || md == 3 || md == 5) {
#pragma unroll
            for (int ai = 0; ai < 2; ++ai)
#pragma unroll
                for (int m = 0; m < 4; ++m) {
                    const int row = row0 + ai * HALF + m * 16;
                    const int seq = row < EPI_TP ? (row >> 11) : 8 + ((row - EPI_TP) >> 3);
                    const float* gr = aux + (size_t)seq * 12288;
                    float* fo = F + (size_t)row * 1024;
#pragma unroll
                    for (int bj = 0; bj < 2; ++bj) {
                        const int c = col0 + bj * HALF;
                        const f32x4 g0 = *(const f32x4*)(gr + c), g1 = *(const f32x4*)(gr + c + 4);
                        if (md != 3) {
                            const float* bo = md == 5 ? aux2 + (size_t)row * 1024 : fo;
                            const f32x4 b0 = *(const f32x4*)(bo + c), b1 = *(const f32x4*)(bo + c + 4);
                            *(f32x4*)(fo + c) = b0 + g0 * acc[ai][bj][m][0];
                            *(f32x4*)(fo + c + 4) = b1 + g1 * acc[ai][bj][m][1];
                        } else {
                            float* po = F + ((size_t)u.ks * 1024 + (row - EPI_TP)) * 1024 + c;
                            *(f32x4*)po = g0 * acc[ai][bj][m][0];
                            *(f32x4*)(po + 4) = g1 * acc[ai][bj][m][1];
                        }
                    }
                }
        } else {
#pragma unroll
            for (int ai = 0; ai < 2; ++ai)
#pragma unroll
                for (int m = 0; m < 4; ++m) {
                    const int row = row0 + ai * HALF + m * 16;
                    float* fo = F + (size_t)row * 12288;
#pragma unroll
                    for (int bj = 0; bj < 2; ++bj) {
                        const int c = col0 + bj * HALF;
                        const f32x4 b0 = *(const f32x4*)(aux + c), b1 = *(const f32x4*)(aux + c + 4);
                        *(f32x4*)(fo + c) = b0 + acc[ai][bj][m][0];
                        *(f32x4*)(fo + c + 4) = b1 + acc[ai][bj][m][1];
                    }
                }
        }
    }
};

template <class Epi, class Sched, bool ALIGN_EPI = false, bool SP2 = false>
__device__ __forceinline__ void gemm_phase(PG8_LAS unsigned char* lds, const Gemm g, const Sched& S, const Epi& E) {
    int tid_ = threadIdx.x; asm volatile("" : "+v"(tid_));
    const int tid = tid_, wid = __builtin_amdgcn_readfirstlane(tid >> 6), lane = tid & 63, wr = wid >> 2, wc = wid & 3, fr = lane & 15, fq = lane >> 4;
    const int K = g.ld, nt = g.K / BK;
    unsigned voffA[2], voffB[2];
#pragma unroll
    for (int i = 0; i < 2; ++i) { int R, C; stage_rc(tid * 16 + i * 8192, R, C); const int Rb = Epi::PERM ? ((R & ~31) + perm32(R & 31)) : R;
        voffA[i] = (unsigned)(R * K + C) * 2u; voffB[i] = (unsigned)(Rb * K + C) * 2u; }
    const size_t kstep = (size_t)(BK * 2);
    const size_t hstep = (size_t)HALF * K * 2;
    const size_t tstep = 2 * hstep;
    const unsigned ldsw = (unsigned)wid * 1024u;
    const int aoff = lds_byte(wr * 64 + fr, fq * 8), boff = lds_byte(wc * 32 + fr, fq * 8);
#define PG8_SA(b, h) (((b) * 2 + (h)) * HTB)
#define PG8_SB(b, h) ((4 + (b) * 2 + (h)) * HTB)
#define PG8_STAGE(bufoff, gbase, voff) do { _Pragma("unroll") for (int _i = 0; _i < 2; ++_i) \
        __builtin_amdgcn_global_load_lds((const unsigned*)((const char*)(gbase) + (voff)[_i]), (PG8_LAS unsigned*)(lds + (bufoff) + ldsw + _i * 8192), 16, 0, 0); } while (0)
#define PG8_LDA(dst, b, h) do { _Pragma("unroll") for (int m = 0; m < 4; ++m) _Pragma("unroll") for (int k = 0; k < 2; ++k) dst[m][k] = *(const PG8_LAS bf16x8*)(lds + PG8_SA(b, h) + aoff + m * 2048 + k * 1024); } while (0)
#define PG8_LDB(dst, b, h) do { _Pragma("unroll") for (int n = 0; n < 2; ++n) _Pragma("unroll") for (int k = 0; k < 2; ++k) dst[n][k] = *(const PG8_LAS bf16x8*)(lds + PG8_SB(b, h) + boff + n * 2048 + k * 1024); } while (0)
#define PG8_MMA(ai, bj, At, Bt) do { __builtin_amdgcn_s_setprio(1); _Pragma("unroll") for (int m = 0; m < 4; ++m) _Pragma("unroll") for (int n = 0; n < 2; ++n) _Pragma("unroll") for (int k = 0; k < 2; ++k) \
        acc[ai][bj][m][n] = __builtin_amdgcn_mfma_f32_16x16x32_bf16(Bt[n][k], At[m][k], acc[ai][bj][m][n], 0, 0, 0); __builtin_amdgcn_s_setprio(0); } while (0)
#define PG8_WAIT_V(n) asm volatile("s_waitcnt vmcnt(" #n ")" ::: "memory")
#define PG8_WAIT_L(n) asm volatile("s_waitcnt lgkmcnt(" #n ")" ::: "memory")
#define PG8_BAR __builtin_amdgcn_s_barrier()
#define PG8_SCHED __builtin_amdgcn_sched_barrier(0)
    Unit cur, nxt; int ui = 0;
    if (!S.next(0, cur)) return;
    f32x4 acc[2][2][4][2];
#pragma unroll
    for (int a = 0; a < 2; ++a)
#pragma unroll
        for (int b = 0; b < 2; ++b)
#pragma unroll
            for (int m = 0; m < 4; ++m)
#pragma unroll
                for (int n = 0; n < 2; ++n) acc[a][b][m][n] = (f32x4){0.f, 0.f, 0.f, 0.f};
    bf16x8 At[4][2], B0[2][2], B1[2][2];
    const size_t ksb = (size_t)g.K * 2;
    const char* cA = (const char*)g.A + (size_t)cur.pm * tstep + cur.ks * ksb; const char* cB = (const char*)g.Bt + (size_t)cur.pn * tstep + cur.ks * ksb;
    S.a_ready(cur);
    if constexpr (SP2) {
        PG8_STAGE(PG8_SB(0, 0), cB, voffB); PG8_STAGE(PG8_SB(0, 1), cB + hstep, voffB); PG8_STAGE(PG8_SA(0, 0), cA, voffA); PG8_STAGE(PG8_SA(0, 1), cA + hstep, voffA);
        if (wr == 1) PG8_BAR;
        PG8_WAIT_V(2); PG8_BAR;
        PG8_STAGE(PG8_SB(1, 0), cB + kstep, voffB); PG8_STAGE(PG8_SA(1, 0), cA + kstep, voffA); PG8_STAGE(PG8_SB(1, 1), cB + hstep + kstep, voffB);
        PG8_WAIT_V(6); PG8_BAR;
    } else {
        PG8_STAGE(PG8_SB(0, 0), cB, voffB); PG8_STAGE(PG8_SA(0, 0), cA, voffA); PG8_STAGE(PG8_SB(0, 1), cB + hstep, voffB); PG8_STAGE(PG8_SA(0, 1), cA + hstep, voffA);
        if (wr == 1) PG8_BAR;
        PG8_WAIT_V(4); PG8_BAR;
        PG8_STAGE(PG8_SB(1, 0), cB + kstep, voffB); PG8_STAGE(PG8_SA(1, 0), cA + kstep, voffA); PG8_STAGE(PG8_SB(1, 1), cB + hstep + kstep, voffB);
        PG8_WAIT_V(6); PG8_BAR;
    }
    for (;;) {
        const bool has_next = S.next(ui + 1, nxt);
        const char* nA = has_next ? (const char*)g.A + (size_t)nxt.pm * tstep + nxt.ks * ksb : cA; const char* nB = has_next ? (const char*)g.Bt + (size_t)nxt.pn * tstep + nxt.ks * ksb : cB;
        for (int t = 0; t < nt; t += 2) {
            const bool last = (t == nt - 2);
            const char* a1 = cA + (size_t)(t + 1) * kstep;
            const char* a2 = last ? nA : cA + (size_t)(t + 2) * kstep; const char* b2 = last ? nB : cB + (size_t)(t + 2) * kstep;
            const char* a3 = a2 + kstep; const char* b3 = b2 + kstep;
            if (last && has_next) S.a_ready(nxt);
            if constexpr (SP2) {
            PG8_LDB(B0, 0, 0); PG8_LDB(B1, 0, 1); PG8_SCHED; PG8_LDA(At, 0, 0); PG8_STAGE(PG8_SA(1, 1), a1 + hstep, voffA);
            PG8_WAIT_V(8); PG8_WAIT_L(0); PG8_BAR; PG8_MMA(0, 0, At, B0); PG8_MMA(0, 1, At, B1); PG8_BAR; PG8_SCHED;
            PG8_LDA(At, 0, 1); PG8_STAGE(PG8_SB(0, 0), b2, voffB); PG8_STAGE(PG8_SB(0, 1), b2 + hstep, voffB); PG8_STAGE(PG8_SA(0, 0), a2, voffA);
            PG8_WAIT_V(8); PG8_WAIT_L(0); PG8_BAR; PG8_MMA(1, 0, At, B0); PG8_MMA(1, 1, At, B1); PG8_BAR; PG8_SCHED;
            PG8_LDB(B0, 1, 0); PG8_LDB(B1, 1, 1); PG8_SCHED; PG8_LDA(At, 1, 0); PG8_STAGE(PG8_SA(0, 1), a2 + hstep, voffA);
            PG8_WAIT_V(8); PG8_WAIT_L(0); PG8_BAR; PG8_MMA(0, 0, At, B0); PG8_MMA(0, 1, At, B1); PG8_BAR; PG8_SCHED;
            PG8_LDA(At, 1, 1); PG8_STAGE(PG8_SB(1, 0), b3, voffB); PG8_STAGE(PG8_SB(1, 1), b3 + hstep, voffB); PG8_STAGE(PG8_SA(1, 0), a3, voffA);
            PG8_WAIT_V(8); PG8_WAIT_L(0); PG8_BAR; PG8_MMA(1, 0, At, B0); PG8_MMA(1, 1, At, B1); PG8_BAR; PG8_SCHED;
            } else {
            PG8_LDB(B0, 0, 0); PG8_SCHED; PG8_LDA(At, 0, 0); PG8_STAGE(PG8_SA(1, 1), a1 + hstep, voffA);
            PG8_WAIT_L(8); PG8_BAR; PG8_WAIT_L(0); PG8_MMA(0, 0, At, B0); PG8_BAR; PG8_SCHED;
            PG8_LDB(B1, 0, 1); PG8_STAGE(PG8_SB(0, 0), b2, voffB);
            PG8_BAR; PG8_WAIT_L(0); PG8_MMA(0, 1, At, B1); PG8_BAR;
            PG8_LDA(At, 0, 1); PG8_STAGE(PG8_SA(0, 0), a2, voffA);
            PG8_BAR; PG8_WAIT_L(0); PG8_MMA(1, 0, At, B0); PG8_BAR; PG8_SCHED;
            PG8_STAGE(PG8_SB(0, 1), b2 + hstep, voffB);
            PG8_WAIT_V(6); PG8_BAR; PG8_MMA(1, 1, At, B1); PG8_BAR;
            PG8_LDB(B0, 1, 0); PG8_SCHED; PG8_LDA(At, 1, 0); PG8_STAGE(PG8_SA(0, 1), a2 + hstep, voffA);
            PG8_WAIT_L(8); PG8_BAR; PG8_WAIT_L(0); PG8_MMA(0, 0, At, B0); PG8_BAR; PG8_SCHED;
            PG8_LDB(B1, 1, 1); PG8_STAGE(PG8_SB(1, 0), b3, voffB);
            PG8_BAR; PG8_WAIT_L(0); PG8_MMA(0, 1, At, B1); PG8_BAR;
            PG8_LDA(At, 1, 1); PG8_STAGE(PG8_SA(1, 0), a3, voffA);
            PG8_BAR; PG8_WAIT_L(0); PG8_MMA(1, 0, At, B0); PG8_BAR; PG8_SCHED;
            PG8_STAGE(PG8_SB(1, 1), b3 + hstep, voffB);
            PG8_WAIT_V(6); PG8_BAR; PG8_MMA(1, 1, At, B1); PG8_BAR;
            }
        }
        if constexpr (ALIGN_EPI) { if (wr == 0) PG8_BAR; }
        if constexpr (!Epi::AFTER_DRAIN) { E(acc, cur, wr, wc, fr, fq); S.done(cur); }
        if (!has_next) break;
#pragma unroll
        for (int a = 0; a < 2; ++a)
#pragma unroll
            for (int b = 0; b < 2; ++b)
#pragma unroll
                for (int m = 0; m < 4; ++m)
#pragma unroll
                    for (int n = 0; n < 2; ++n) acc[a][b][m][n] = (f32x4){0.f, 0.f, 0.f, 0.f};
        cur = nxt; cA = nA; cB = nB; ++ui;
        if constexpr (ALIGN_EPI) { if (wr == 1) PG8_BAR; }
    }
    PG8_WAIT_V(0);
    if constexpr (!ALIGN_EPI) { if (wr == 0) PG8_BAR; }
    PG8_BAR;
    if constexpr (Epi::AFTER_DRAIN) { E.fused(acc, cur, wr, wc, fr, fq, lds, wid, lane); S.done(cur); }
#undef PG8_SA
#undef PG8_SB
#undef PG8_STAGE
#undef PG8_LDA
#undef PG8_LDB
#undef PG8_MMA
#undef PG8_WAIT_V
#undef PG8_WAIT_L
#undef PG8_BAR
#undef PG8_SCHED
}
}

#define LAS __attribute__((address_space(3)))
typedef unsigned short bf16;
typedef unsigned v4u __attribute__((ext_vector_type(4)));
typedef unsigned v2u __attribute__((ext_vector_type(2)));
typedef float f32x4 __attribute__((ext_vector_type(4)));
typedef float f32x2 __attribute__((ext_vector_type(2)));
typedef short bf16x8 __attribute__((ext_vector_type(8)));
typedef LAS unsigned char* ldsp;

constexpr int NWAVES = 8, NTHR = 512;
constexpr int D = 1024, TP = 16384, TS = 1024, T = TP + TS, NSEQ = 136;
constexpr int DGM = 2048, DIN = 2048, CONVD = 4096, NPROJ = 6176, NPROJ_PAD = 6400, ZXP = 6144, DFF = 4096, NMODC = 12288;
constexpr float EPS = 1e-6f;
constexpr int LDS_BYTES = 163840;

constexpr size_t MiB = 1u << 20;
constexpr size_t WS_WADA = 0;
constexpr size_t WS_WGIN = WS_WADA + 24 * MiB;
constexpr size_t WS_WGOUT = WS_WGIN + 8 * MiB;
constexpr size_t WS_WSIN = WS_WGOUT + 4 * MiB;
constexpr size_t WS_WSOUT = WS_WSIN + 13 * MiB;
constexpr size_t WS_WM1 = WS_WSOUT + 4 * MiB;
constexpr size_t WS_WM2 = WS_WM1 + 16 * MiB;
constexpr size_t WS_CS = WS_WM2 + 16 * MiB;
constexpr size_t WS_MOD = WS_CS + 1 * MiB;
constexpr size_t WS_H = WS_MOD + 12 * MiB;
constexpr size_t WS_BIG = WS_H + 34 * MiB;
constexpr size_t WS_G = WS_BIG + 204 * MiB;
constexpr size_t WS_DT = WS_G + 68 * MiB;
constexpr size_t WS_STATS = WS_DT + 3 * MiB;
constexpr size_t WS_SS = WS_STATS + 1 * MiB;
constexpr size_t WS_CTL = WS_SS + 3 * MiB;
constexpr size_t CTL_BYTES = 16384;
constexpr size_t WS_PART = WS_CTL + 1 * MiB;
constexpr int NSPLIT = 8;
constexpr size_t WS_END = WS_PART + 32 * MiB;
constexpr int MISC_OFF = LDS_BYTES - 64;

constexpr size_t O_Y = 0;
constexpr size_t O_VP = (size_t)T * D;
constexpr size_t O_VS = O_VP + (size_t)8 * 128 * 2048;
constexpr size_t O_SP = O_VS + (size_t)128 * 8 * 2048;
constexpr size_t O_CP = O_SP + (size_t)8 * 32 * 64 * 128;
constexpr size_t O_SSS = O_CP + (size_t)8 * 3 * 4096;
constexpr size_t O_CSS = O_SSS + (size_t)128 * 32 * 64 * 128;
constexpr size_t O_END = O_CSS + (size_t)128 * 3 * 4096;

struct Args { const float* in[27]; float* out; unsigned char* ws; int ph_lo, ph_hi; };
typedef const __attribute__((address_space(4))) Args CArgs;

#define LDS_WAIT() asm volatile("s_waitcnt lgkmcnt(0)" ::: "memory")
#define LDS_BARRIER() do { asm volatile("s_waitcnt lgkmcnt(0)" ::: "memory"); __builtin_amdgcn_s_barrier(); asm volatile("" ::: "memory"); } while (0)
__device__ __forceinline__ unsigned f2bf(float f) { unsigned u = __builtin_bit_cast(unsigned, f); return (u + 0x7fffu + ((u >> 16) & 1u)) >> 16; }
__device__ __forceinline__ unsigned pk2(float lo, float hi) { unsigned r; asm("v_cvt_pk_bf16_f32 %0, %1, %2" : "=v"(r) : "v"(lo), "v"(hi)); return r; }
__device__ __forceinline__ float bf_lo(unsigned w) { return __builtin_bit_cast(float, w << 16); }
__device__ __forceinline__ float bf_hi(unsigned w) { return __builtin_bit_cast(float, w & 0xffff0000u); }
__device__ __forceinline__ float bf1(bf16 b) { return __builtin_bit_cast(float, (unsigned)b << 16); }
__device__ __forceinline__ float wave_sum(float v) {
#pragma unroll
    for (int o = 1; o < 64; o <<= 1) v += __shfl_xor(v, o);
    return v;
}
__device__ __forceinline__ float silu_f(float x) { return x * __builtin_amdgcn_rcpf(1.0f + __builtin_amdgcn_exp2f(-1.4426950409f * x)); }
__device__ __forceinline__ float exp_f(float x) { return __builtin_amdgcn_exp2f(1.4426950409f * x); }
__device__ __forceinline__ float softplus_f(float x) { return x > 20.f ? x : 0.6931471806f * __builtin_amdgcn_logf(1.0f + __builtin_amdgcn_exp2f(1.4426950409f * x)); }
__device__ __forceinline__ int seq_of_row(int row) { return row < TP ? (row >> 11) : 8 + ((row - TP) >> 3); }

__device__ __forceinline__ void p0_transpose_item(const float* W, int K, int N, bf16* WT, int row_off, const float* kscale, LAS float* scr, int item, int lane) {
    const int nblk = N / 32, kb = item / nblk, nb = item % nblk, k0 = 64 * kb, n0 = 32 * nb;
#pragma unroll 8
    for (int i = 0; i < 32; ++i) { const int kk = 2 * i + (lane >> 5); float v = W[(size_t)(k0 + kk) * N + n0 + (lane & 31)]; if (kscale) v *= kscale[k0 + kk]; scr[kk * 33 + (lane & 31)] = v; }
    LDS_WAIT(); asm volatile("" ::: "memory");
    const int c = lane & 7;
#pragma unroll
    for (int j = 0; j < 4; ++j) { const int n = (lane >> 3) + 8 * j; const LAS float* s = scr + (8 * c) * 33 + n;
        v4u o; o.x = pk2(s[0 * 33], s[1 * 33]); o.y = pk2(s[2 * 33], s[3 * 33]); o.z = pk2(s[4 * 33], s[5 * 33]); o.w = pk2(s[6 * 33], s[7 * 33]);
        *(v4u*)(WT + (size_t)(row_off + n0 + n) * K + k0 + 8 * c) = o; }
    LDS_WAIT(); asm volatile("" ::: "memory");
}

constexpr int I_ADA = 16 * 192, I_GIN = 16 * 128, I_GOUT = 32 * 32, I_SIN = 16 * 193, I_SOUT = 32 * 32, I_M1 = 16 * 128, I_M2 = 64 * 32;
constexpr int NITEMS = 2 * I_ADA + I_GIN + I_GOUT + I_SIN + I_SOUT + 2 * I_M1 + 2 * I_M2;
constexpr int IT_GIN = 2 * I_ADA, IT_GOUT = IT_GIN + I_GIN, IT_SIN = IT_GOUT + I_GOUT, IT_SOUT = IT_SIN + I_SIN, IT_M1A = IT_SOUT + I_SOUT, IT_M1B = IT_M1A + I_M1, IT_M2A = IT_M1B + I_M1, IT_M2B = IT_M2A + I_M2;
__device__ __forceinline__ void p0_prologue(CArgs& a, ldsp lds, int it_lo, int it_hi, int w, int nw, bool misc, int wave, int lane) {
    unsigned char* ws = a.ws;
    LAS float* scr = (LAS float*)(lds + wave * 16384);
    const int gw = w, NGW = nw;
    for (int it = it_lo + w; it < it_hi; it += nw) {
        int r = it;
        if (r < I_ADA) { p0_transpose_item(a.in[6], 1024, 6144, (bf16*)(ws + WS_WADA), 0, nullptr, scr, r, lane); continue; } r -= I_ADA;
        if (r < I_ADA) { p0_transpose_item(a.in[6] + (size_t)1024 * 6144, 1024, 6144, (bf16*)(ws + WS_WADA), 6144, nullptr, scr, r, lane); continue; } r -= I_ADA;
        if (r < I_GIN) { p0_transpose_item(a.in[10], 1024, 4096, (bf16*)(ws + WS_WGIN), 0, nullptr, scr, r, lane); continue; } r -= I_GIN;
        if (r < I_GOUT) { p0_transpose_item(a.in[15], 2048, 1024, (bf16*)(ws + WS_WGOUT), 0, nullptr, scr, r, lane); continue; } r -= I_GOUT;
        if (r < I_SIN) { p0_transpose_item(a.in[16], 1024, NPROJ, (bf16*)(ws + WS_WSIN), 0, nullptr, scr, r, lane); continue; } r -= I_SIN;
        if (r < I_SOUT) { p0_transpose_item(a.in[23], 2048, 1024, (bf16*)(ws + WS_WSOUT), 0, a.in[22], scr, r, lane); continue; } r -= I_SOUT;
        if (r < I_M1) { p0_transpose_item(a.in[24], 1024, 4096, (bf16*)(ws + WS_WM1), 0, nullptr, scr, r, lane); continue; } r -= I_M1;
        if (r < I_M1) { p0_transpose_item(a.in[24] + (size_t)1024 * 4096, 1024, 4096, (bf16*)(ws + WS_WM1), 4096, nullptr, scr, r, lane); continue; } r -= I_M1;
        if (r < I_M2) { p0_transpose_item(a.in[25], 4096, 1024, (bf16*)(ws + WS_WM2), 0, nullptr, scr, r, lane); continue; } r -= I_M2;
        p0_transpose_item(a.in[25] + (size_t)4096 * 1024, 4096, 1024, (bf16*)(ws + WS_WM2), 1024, nullptr, scr, r, lane);
    }
    if (!misc) return;
    for (int s = gw; s < 256; s += NGW) {
        bf16* o = (bf16*)(ws + WS_CS) + (size_t)s * 1024;
        const float* c = s < 8 ? a.in[2] + (size_t)s * 1024 : a.in[3] + (size_t)(s - 8) * 1024;
#pragma unroll
        for (int j = 0; j < 4; ++j) {
            const int col = lane * 4 + 256 * j; v2u w; w.x = 0u; w.y = 0u;
            if (s < NSEQ) { const f32x4 v = *(const f32x4*)(c + col); w.x = pk2(silu_f(v[0]), silu_f(v[1])); w.y = pk2(silu_f(v[2]), silu_f(v[3])); }
            *(v2u*)(o + col) = w;
        }
    }
    { float* st = (float*)(ws + WS_STATS); for (int i = gw * 64 + lane; i < T * 2; i += NGW * 64) st[i] = 0.f; }
    { v4u* p = (v4u*)((bf16*)(ws + WS_WSIN) + (size_t)NPROJ * 1024); const int n = (NPROJ_PAD - NPROJ) * 1024 / 8; const v4u z = {0u, 0u, 0u, 0u};
      for (int i = gw * 64 + lane; i < n; i += NGW * 64) p[i] = z; }
}

__device__ __forceinline__ void normmod_phase(const float* x0, const float* x1, const float* gamma, const float* shift, const float* scale, bf16* H, float* xcopy, const float* part, int gw, int NGW, int lane) {
    int row = gw; if (row >= T) return;
    f32x4 gm4[4];
#pragma unroll
    for (int j = 0; j < 4; ++j) gm4[j] = *(const f32x4*)(gamma + lane * 4 + 256 * j);
    f32x4 v[4], sc[4], sh[4];
    {
        const float* xr = row < TP ? x0 + (size_t)row * D : x1 + (size_t)(row - TP) * D; const int seq = seq_of_row(row);
#pragma unroll
        for (int j = 0; j < 4; ++j) { const int c = lane * 4 + 256 * j; v[j] = *(const f32x4*)(xr + c); sc[j] = *(const f32x4*)(scale + (size_t)seq * NMODC + c); sh[j] = *(const f32x4*)(shift + (size_t)seq * NMODC + c); }
    }
    for (; row < T; row += NGW) {
        const int nrow = row + NGW;
        f32x4 vn[4], scn[4], shn[4];
        if (nrow < T) {
            const float* xn = nrow < TP ? x0 + (size_t)nrow * D : x1 + (size_t)(nrow - TP) * D; const int seqn = seq_of_row(nrow);
#pragma unroll
            for (int j = 0; j < 4; ++j) { const int c = lane * 4 + 256 * j; vn[j] = *(const f32x4*)(xn + c); scn[j] = *(const f32x4*)(scale + (size_t)seqn * NMODC + c); shn[j] = *(const f32x4*)(shift + (size_t)seqn * NMODC + c); }
        } else {
#pragma unroll
            for (int j = 0; j < 4; ++j) { vn[j] = v[j]; scn[j] = sc[j]; shn[j] = sh[j]; }
        }
        float ss = 0.f;
        if (part && row >= TP) {
            float* xw = const_cast<float*>(x1) + (size_t)(row - TP) * D;
#pragma unroll
            for (int j = 0; j < 4; ++j) {
#pragma unroll
                for (int k = 0; k < NSPLIT; ++k) v[j] += *(const f32x4*)(part + ((size_t)k * 1024 + (row - TP)) * 1024 + lane * 4 + 256 * j);
                *(f32x4*)(xw + lane * 4 + 256 * j) = v[j];
            }
        }
#pragma unroll
        for (int j = 0; j < 4; ++j) ss += (v[j][0] * v[j][0] + v[j][1] * v[j][1]) + (v[j][2] * v[j][2] + v[j][3] * v[j][3]);
        if (xcopy && row >= TP) {
#pragma unroll
            for (int j = 0; j < 4; ++j) *(f32x4*)(xcopy + (size_t)row * D + lane * 4 + 256 * j) = v[j];
        }
        const float rstd = 1.0f / sqrtf(wave_sum(ss) * (1.0f / D) + EPS);
#pragma unroll
        for (int j = 0; j < 4; ++j) {
            const int c = lane * 4 + 256 * j;
            const f32x4 o = v[j] * rstd * gm4[j] * (1.0f + sc[j]) + sh[j];
            v2u w; w.x = pk2(o[0], o[1]); w.y = pk2(o[2], o[3]);
            *(v2u*)(H + (size_t)row * D + c) = w;
        }
#pragma unroll
        for (int j = 0; j < 4; ++j) { v[j] = vn[j]; sc[j] = scn[j]; sh[j] = shn[j]; }
    }
}
__device__ __forceinline__ void finalnorm_phase(float* x, const float* gamma, const float* part, int gw, int NGW, int lane) {
    int row = gw; if (row >= T) return;
    f32x4 gm4[4], v[4];
#pragma unroll
    for (int j = 0; j < 4; ++j) { gm4[j] = *(const f32x4*)(gamma + lane * 4 + 256 * j); v[j] = *(const f32x4*)(x + (size_t)row * D + lane * 4 + 256 * j); }
    for (; row < T; row += NGW) {
        float* xr = x + (size_t)row * D;
        const int nrow = row + NGW; f32x4 vn[4];
#pragma unroll
        for (int j = 0; j < 4; ++j) vn[j] = nrow < T ? *(const f32x4*)(x + (size_t)nrow * D + lane * 4 + 256 * j) : v[j];
        if (part && row >= TP) {
#pragma unroll
            for (int j = 0; j < 4; ++j) {
#pragma unroll
                for (int k = 0; k < NSPLIT; ++k) v[j] += *(const f32x4*)(part + ((size_t)k * 1024 + (row - TP)) * 1024 + lane * 4 + 256 * j);
            }
        }
        float ss = 0.f;
#pragma unroll
        for (int j = 0; j < 4; ++j) ss += (v[j][0] * v[j][0] + v[j][1] * v[j][1]) + (v[j][2] * v[j][2] + v[j][3] * v[j][3]);
        const float rstd = 1.0f / sqrtf(wave_sum(ss) * (1.0f / D) + EPS);
#pragma unroll
        for (int j = 0; j < 4; ++j) { const int c = lane * 4 + 256 * j; *(f32x4*)(xr + c) = v[j] * rstd * gm4[j]; }
#pragma unroll
        for (int j = 0; j < 4; ++j) v[j] = vn[j];
    }
}
__device__ __forceinline__ void groupnorm_phase(bf16* G, const float* SS, int gw, int NGW, int lane) {
    int row = gw; if (row >= T) return;
    v4u w[4]; f32x4 s4[4];
#pragma unroll
    for (int j = 0; j < 4; ++j) { const int c = lane * 8 + 512 * j; w[j] = *(const v4u*)(G + (size_t)row * DIN + c); s4[j] = *(const f32x4*)(SS + (size_t)row * 32 + 4 * (c >> 8)); }
    for (; row < T; row += NGW) {
        bf16* gr = G + (size_t)row * DIN;
        const int nrow = row + NGW; v4u wn[4]; f32x4 sn[4];
#pragma unroll
        for (int j = 0; j < 4; ++j) { const int c = lane * 8 + 512 * j;
            if (nrow < T) { wn[j] = *(const v4u*)(G + (size_t)nrow * DIN + c); sn[j] = *(const f32x4*)(SS + (size_t)nrow * 32 + 4 * (c >> 8)); } else { wn[j] = w[j]; sn[j] = s4[j]; } }
#pragma unroll
        for (int j = 0; j < 4; ++j) {
            const int c = lane * 8 + 512 * j;
            const float rstd = 1.0f / sqrtf(((s4[j][0] + s4[j][1]) + (s4[j][2] + s4[j][3])) * (1.0f / 256.f) + EPS);
            v4u o;
            o.x = pk2(bf_lo(w[j].x) * rstd, bf_hi(w[j].x) * rstd); o.y = pk2(bf_lo(w[j].y) * rstd, bf_hi(w[j].y) * rstd);
            o.z = pk2(bf_lo(w[j].z) * rstd, bf_hi(w[j].z) * rstd); o.w = pk2(bf_lo(w[j].w) * rstd, bf_hi(w[j].w) * rstd);
            *(v4u*)(gr + c) = o;
        }
#pragma unroll
        for (int j = 0; j < 4; ++j) { w[j] = wn[j]; s4[j] = sn[j]; }
    }
}

constexpr int LP = 136;
#define MFMA16(a, b, c) __builtin_amdgcn_mfma_f32_16x16x32_bf16((a), (b), (c), 0, 0, 0)
typedef short s16x4 __attribute__((ext_vector_type(4)));
__device__ __forceinline__ bf16x8 tr_frag(const LAS bf16* tile, int pitch, int k0, int c, int lane) {
    const int g = lane >> 4, q = (lane & 15) >> 2, p = lane & 3;
    const LAS bf16* a0 = tile + (k0 + 8 * g + q) * pitch + 16 * c + 4 * p;
    const s16x4 lo = __builtin_amdgcn_ds_read_tr16_b64_v4i16((LAS s16x4*)a0);
    const s16x4 hi = __builtin_amdgcn_ds_read_tr16_b64_v4i16((LAS s16x4*)(a0 + 4 * pitch));
    return __builtin_shufflevector(lo, hi, 0, 1, 2, 3, 4, 5, 6, 7);
}
__device__ __forceinline__ bf16x8 tr_frag_pair(const LAS bf16* tile, int pitch, int k0, int c2, int n, int lane) {
    const int g = lane >> 4, q = (lane & 15) >> 2, p = lane & 3;
    const LAS bf16* a0 = tile + (k0 + 8 * g + q) * pitch + 32 * c2 + 8 * p + 4 * n;
    const s16x4 lo = __builtin_amdgcn_ds_read_tr16_b64_v4i16((LAS s16x4*)a0);
    const s16x4 hi = __builtin_amdgcn_ds_read_tr16_b64_v4i16((LAS s16x4*)(a0 + 4 * pitch));
    return __builtin_shufflevector(lo, hi, 0, 1, 2, 3, 4, 5, 6, 7);
}
constexpr int VP = 272;
__device__ __forceinline__ void gate_prompt_unit(CArgs& a, ldsp lds, int unit, int tid) {
    const int g = unit & 7, bc = unit >> 3, c = bc & 15, b = bc >> 4, row0 = bc * 128;
    const int wid = tid >> 6, lane = tid & 63, fr = lane & 15, fq = lane >> 4, wr = wid >> 2, wc = wid & 3;
    const bf16* Z = (const bf16*)(a.ws + WS_BIG); bf16* G = (bf16*)(a.ws + WS_G); const float* stats = (const float*)(a.ws + WS_STATS);
    LAS bf16* WsA = (LAS bf16*)lds; LAS bf16* vT = (LAS bf16*)(lds + 128 * LP * 2);
    const int w0 = (tid & 31) * 8, sb = tid >> 5;
    v4u raw[8]; float mu[8], rs[8];
#pragma unroll
    for (int i = 0; i < 8; ++i) {
        const int row = row0 + sb + 16 * i;
        raw[i] = *(const v4u*)(Z + (size_t)row * 4096 + 2048 + g * 256 + w0);
        const float s1 = stats[2 * row], s2 = stats[2 * row + 1];
        mu[i] = s1 * (1.f / 2048.f); rs[i] = s2;
    }
    const float* lng = a.in[11] + g * 256 + w0; const float* lnb = a.in[12] + g * 256 + w0;
    const f32x4 g0 = *(const f32x4*)(lng), g1 = *(const f32x4*)(lng + 4), b0 = *(const f32x4*)(lnb), b1 = *(const f32x4*)(lnb + 4);
    const float* w_s = a.in[13] + (size_t)g * 16384;
    {
        const int t0 = tid >> 5, s0 = (tid & 31) * 4;
#pragma unroll
        for (int i = 0; i < 8; ++i) {
            const int t = t0 + 16 * i;
            const f32x4 v = *(const f32x4*)(w_s + t * 128 + s0);
            v2u w; w.x = pk2(s0 <= t ? v[0] : 0.f, s0 + 1 <= t ? v[1] : 0.f); w.y = pk2(s0 + 2 <= t ? v[2] : 0.f, s0 + 3 <= t ? v[3] : 0.f);
            *(LAS v2u*)(WsA + t * LP + s0) = w;
        }
    }
#pragma unroll
    for (int i = 0; i < 8; ++i) {
        const int s = sb + 16 * i;
        const float m = mu[i], var = rs[i] * (1.f / 2048.f) - m * m, rstd = 1.0f / sqrtf(var + EPS);
        f32x4 v0, v1;
        v0[0] = (bf_lo(raw[i].x) - m) * rstd * g0[0] + b0[0]; v0[1] = (bf_hi(raw[i].x) - m) * rstd * g0[1] + b0[1];
        v0[2] = (bf_lo(raw[i].y) - m) * rstd * g0[2] + b0[2]; v0[3] = (bf_hi(raw[i].y) - m) * rstd * g0[3] + b0[3];
        v1[0] = (bf_lo(raw[i].z) - m) * rstd * g1[0] + b1[0]; v1[1] = (bf_hi(raw[i].z) - m) * rstd * g1[1] + b1[1];
        v1[2] = (bf_lo(raw[i].w) - m) * rstd * g1[2] + b1[2]; v1[3] = (bf_hi(raw[i].w) - m) * rstd * g1[3] + b1[3];
        { v4u w; w.x = pk2(v0[0], v0[1]); w.y = pk2(v0[2], v0[3]); w.z = pk2(v1[0], v1[1]); w.w = pk2(v1[2], v1[3]); *(LAS v4u*)(vT + s * VP + w0) = w; }
        if (c == 15) { float* o = a.out + O_VP + ((size_t)(b * 128 + s)) * 2048 + g * 256 + w0; *(f32x4*)o = v0; *(f32x4*)(o + 4) = v1; }
    }
    v4u uu[4][2];
#pragma unroll
    for (int m = 0; m < 4; ++m)
#pragma unroll
        for (int c2 = 0; c2 < 2; ++c2) uu[m][c2] = *(const v4u*)(Z + (size_t)(row0 + wr * 64 + m * 16 + fr) * 4096 + g * 256 + wc * 64 + c2 * 32 + fq * 8);
    LDS_BARRIER();
    f32x4 acc[4][4];
#pragma unroll
    for (int m = 0; m < 4; ++m)
#pragma unroll
        for (int n = 0; n < 4; ++n) acc[m][n] = (f32x4){0.f, 0.f, 0.f, 0.f};
    const int kend = wr * 64 + 64;
    for (int k0 = 0; k0 < kend; k0 += 32) {
        bf16x8 af[4], bfr[4];
#pragma unroll
        for (int m = 0; m < 4; ++m) af[m] = *(const LAS bf16x8*)(WsA + (wr * 64 + m * 16 + fr) * LP + k0 + fq * 8);
#pragma unroll
        for (int n = 0; n < 4; ++n) bfr[n] = tr_frag_pair(vT, VP, k0, wc * 2 + (n >> 1), n & 1, lane);
#pragma unroll
        for (int m = 0; m < 4; ++m)
#pragma unroll
            for (int n = 0; n < 4; ++n) acc[m][n] = MFMA16(bfr[n], af[m], acc[m][n]);
    }
    const float* b_s = a.in[14] + g * 128;
#pragma unroll
    for (int m = 0; m < 4; ++m) {
        const int t = wr * 64 + m * 16 + fr, row = row0 + t; const float bs = b_s[t];
#pragma unroll
        for (int c2 = 0; c2 < 2; ++c2) {
            const int col = g * 256 + wc * 64 + c2 * 32 + fq * 8;
            const v4u u = uu[m][c2]; const f32x4 a0 = acc[m][2 * c2], a1 = acc[m][2 * c2 + 1];
            v4u o;
            o.x = pk2(bf_lo(u.x) * (a0[0] + bs), bf_hi(u.x) * (a0[1] + bs)); o.y = pk2(bf_lo(u.y) * (a0[2] + bs), bf_hi(u.y) * (a0[3] + bs));
            o.z = pk2(bf_lo(u.z) * (a1[0] + bs), bf_hi(u.z) * (a1[1] + bs)); o.w = pk2(bf_lo(u.w) * (a1[2] + bs), bf_hi(u.w) * (a1[3] + bs));
            *(v4u*)(G + (size_t)row * DGM + col) = o;
        }
    }
    LDS_BARRIER();
}
__device__ __forceinline__ void gate_sample_unit(CArgs& a, int bsq, int tid) {
    const bf16* Z = (const bf16*)(a.ws + WS_BIG); bf16* G = (bf16*)(a.ws + WS_G); const float* stats = (const float*)(a.ws + WS_STATS);
    const int col = tid * 4, g = col >> 8, row0 = TP + bsq * 8;
    const f32x4 lg = *(const f32x4*)(a.in[11] + col), lb = *(const f32x4*)(a.in[12] + col);
    v2u raw[8], uu[8]; float s1[8], s2[8];
#pragma unroll
    for (int t = 0; t < 8; ++t) {
        const int row = row0 + t;
        raw[t] = *(const v2u*)(Z + (size_t)row * 4096 + 2048 + col); uu[t] = *(const v2u*)(Z + (size_t)row * 4096 + col);
        s1[t] = stats[2 * row]; s2[t] = stats[2 * row + 1];
    }
    f32x4 v[8];
#pragma unroll
    for (int t = 0; t < 8; ++t) {
        const float mu = s1[t] * (1.f / 2048.f), var = s2[t] * (1.f / 2048.f) - mu * mu, rstd = 1.0f / sqrtf(var + EPS);
        v[t][0] = (bf_lo(raw[t].x) - mu) * rstd * lg[0] + lb[0]; v[t][1] = (bf_hi(raw[t].x) - mu) * rstd * lg[1] + lb[1];
        v[t][2] = (bf_lo(raw[t].y) - mu) * rstd * lg[2] + lb[2]; v[t][3] = (bf_hi(raw[t].y) - mu) * rstd * lg[3] + lb[3];
        *(f32x4*)(a.out + O_VS + (size_t)(bsq * 8 + t) * 2048 + col) = v[t];
    }
    const float* w_s = a.in[13] + (size_t)g * 16384; const float* b_s = a.in[14] + g * 128;
#pragma unroll
    for (int t = 0; t < 8; ++t) {
        const int row = row0 + t; const float bs = b_s[t];
        f32x4 s = (f32x4){bs, bs, bs, bs};
#pragma unroll
        for (int q = 0; q < 8; ++q) if (q <= t) s += w_s[t * 128 + q] * v[q];
        const v2u u = uu[t];
        v2u o; o.x = pk2(bf_lo(u.x) * s[0], bf_hi(u.x) * s[1]); o.y = pk2(bf_lo(u.y) * s[2], bf_hi(u.y) * s[3]);
        *(v2u*)(G + (size_t)row * DGM + col) = o;
    }
}

constexpr int TPI = 144, XPI = 72;
constexpr int L_CM = 0, L_BM = 36864, L_BWT = 73728, L_XST = 110592, L_STB = 129024, L_ACUM = 146432, L_DTS = 146944, L_WS = 147456, L_EAC = 147968, L_CWP = 148480;
__device__ __forceinline__ void cv8(const v4u w, float (&r)[8]) {
    r[0] = bf_lo(w.x); r[1] = bf_hi(w.x); r[2] = bf_lo(w.y); r[3] = bf_hi(w.y); r[4] = bf_lo(w.z); r[5] = bf_hi(w.z); r[6] = bf_lo(w.w); r[7] = bf_hi(w.w);
}
__device__ __forceinline__ void ssd_prompt_unit(CArgs& a, ldsp lds, int b, int h, int tid) {
    const int g = h >> 2, wid = tid >> 6, lane = tid & 63, fr = lane & 15, fq = lane >> 4, wr = wid >> 2, wc = wid & 3;
    const bf16* ZX = (const bf16*)(a.ws + WS_BIG); bf16* G = (bf16*)(a.ws + WS_G); const float* DT = (const float*)(a.ws + WS_DT); float* SS = (float*)(a.ws + WS_SS);
    LAS bf16* CM = (LAS bf16*)(lds + L_CM); LAS bf16* BM = (LAS bf16*)(lds + L_BM); LAS bf16* BWT = (LAS bf16*)(lds + L_BWT);
    LAS bf16* XST = (LAS bf16*)(lds + L_XST); LAS bf16* STB = (LAS bf16*)(lds + L_STB);
    LAS float* ACUM = (LAS float*)(lds + L_ACUM); LAS float* DTS = (LAS float*)(lds + L_DTS); LAS float* WSV = (LAS float*)(lds + L_WS); LAS float* EAC = (LAS float*)(lds + L_EAC);
    const float A_h = -expf(a.in[20][h]), D_h = a.in[21][h], dtb = a.in[19][h];
    f32x4 st[4];
#pragma unroll
    for (int m = 0; m < 4; ++m) st[m] = (f32x4){0.f, 0.f, 0.f, 0.f};
    const int ck = tid % 40, tg = tid / 40, tb = tg * 11;
    int seg, ch0, cl;
    if (ck < 8) { seg = 0; cl = ck * 8; ch0 = h * 64 + cl; } else if (ck < 24) { seg = 1; cl = (ck - 8) * 8; ch0 = 2048 + g * 128 + cl; } else { seg = 2; cl = (ck - 24) * 8; ch0 = 3072 + g * 128 + cl; }
    LAS float* CWP = (LAS float*)(lds + L_CWP);
    {
        const float* conv_w = a.in[17]; const float* conv_b = a.in[18];
        for (int i = tid; i < 5 * 320; i += NTHR) { const int k = i / 320, cc = i % 320, ch = cc < 64 ? h * 64 + cc : (cc < 192 ? 2048 + g * 128 + (cc - 64) : 3072 + g * 128 + (cc - 192)); CWP[i] = k < 4 ? conv_w[k * 4096 + ch] : conv_b[ch]; }
    }
    const int ccl = (seg == 0 ? 0 : (seg == 1 ? 64 : 192)) + cl;
    v4u pf[14]; float dpf0 = 0.f, dpf1 = 0.f;
#define SSD_ISSUE(cn) do { const bf16* zp_ = ZX + (size_t)(b * 2048 + (cn) * 128) * ZXP + 2048 + ch0; \
        _Pragma("unroll") for (int i_ = 0; i_ < 14; ++i_) { const int rel_ = tb + i_ - 3; \
            if (rel_ < 128 && ((cn) > 0 || rel_ >= 0)) pf[i_] = *(const v4u*)(zp_ + (long)rel_ * ZXP); else pf[i_] = (v4u){0u, 0u, 0u, 0u}; } \
        } while (0)
#define SSD_DT(cn) do { if (wid == 0) { const float* dp_ = DT + (size_t)(b * 2048 + (cn) * 128 + 2 * lane) * 32 + h; dpf0 = dp_[0]; dpf1 = dp_[32]; } } while (0)
    SSD_DT(0);
    for (int c = 0; c < 16; ++c) {
        const int row0 = b * 2048 + c * 128;
        SSD_ISSUE(c);
        const float dr0 = dpf0, dr1 = dpf1;
        if (c < 15) SSD_DT(c + 1);
        const int trow = wid * 16 + fr;
        if (wid == 0) {
            const int t0 = 2 * lane;
            const float d0 = softplus_f(dr0 + dtb), d1 = softplus_f(dr1 + dtb);
            const float a0 = d0 * A_h, a1 = d1 * A_h, pr = a0 + a1; float inc = pr;
#pragma unroll
            for (int o = 1; o < 64; o <<= 1) { const float n = __shfl_up(inc, o); if (lane >= o) inc += n; }
            const float exc = inc - pr;
            ACUM[t0] = exc + a0; ACUM[t0 + 1] = inc; DTS[t0] = d0; DTS[t0 + 1] = d1;
        }
#pragma unroll
        for (int m = 0; m < 4; ++m) { v2u w; w.x = pk2(st[m][0], st[m][1]); w.y = pk2(st[m][2], st[m][3]); *(LAS v2u*)(STB + (m * 16 + fr) * LP + wid * 16 + fq * 4) = w; }
        LDS_BARRIER();
        const float aend = ACUM[127];
        {
            f32x2 cw0[4], cw1[4], cw2[4], cw3[4], cb[4];
#pragma unroll
            for (int j = 0; j < 4; ++j) { cw0[j] = *(const LAS f32x2*)(CWP + ccl + 2 * j); cw1[j] = *(const LAS f32x2*)(CWP + 320 + ccl + 2 * j); cw2[j] = *(const LAS f32x2*)(CWP + 640 + ccl + 2 * j);
                                          cw3[j] = *(const LAS f32x2*)(CWP + 960 + ccl + 2 * j); cb[j] = *(const LAS f32x2*)(CWP + 1280 + ccl + 2 * j); }
            LAS bf16* rbase = seg == 0 ? XST + tb * XPI + cl : (seg == 1 ? BM : CM) + tb * TPI + cl;
            LAS bf16* r2base = BWT + tb * TPI + cl;
            LAS float* wbase = DTS + tb; LAS float* abase = ACUM + tb;
            int nval = 128 - tb;
            asm volatile("" : "+v"(rbase), "+v"(r2base), "+v"(wbase), "+v"(abase), "+v"(nval));
            f32x2 rr[4][4];
#define CVP(W_, R_) do { R_[0] = (f32x2){bf_lo(W_.x), bf_hi(W_.x)}; R_[1] = (f32x2){bf_lo(W_.y), bf_hi(W_.y)}; R_[2] = (f32x2){bf_lo(W_.z), bf_hi(W_.z)}; R_[3] = (f32x2){bf_lo(W_.w), bf_hi(W_.w)}; } while (0)
            CVP(pf[0], rr[0]); CVP(pf[1], rr[1]); CVP(pf[2], rr[2]);
#pragma unroll
            for (int i = 0; i < 11; ++i) {
                CVP(pf[i + 3], rr[(i + 3) & 3]);
                if (i < nval) {
                    f32x2 v[4], x[4], e[4];
#pragma unroll
                    for (int j = 0; j < 4; ++j) x[j] = cb[j] + cw0[j] * rr[i & 3][j];
#pragma unroll
                    for (int j = 0; j < 4; ++j) x[j] = x[j] + cw1[j] * rr[(i + 1) & 3][j];
#pragma unroll
                    for (int j = 0; j < 4; ++j) x[j] = x[j] + cw2[j] * rr[(i + 2) & 3][j];
#pragma unroll
                    for (int j = 0; j < 4; ++j) x[j] = x[j] + cw3[j] * rr[(i + 3) & 3][j];
#pragma unroll
                    for (int j = 0; j < 4; ++j) e[j] = x[j] * (-1.4426950409f);
#pragma unroll
                    for (int j = 0; j < 4; ++j) { e[j].x = __builtin_amdgcn_exp2f(e[j].x); e[j].y = __builtin_amdgcn_exp2f(e[j].y); }
#pragma unroll
                    for (int j = 0; j < 4; ++j) e[j] = e[j] + 1.0f;
#pragma unroll
                    for (int j = 0; j < 4; ++j) { e[j].x = __builtin_amdgcn_rcpf(e[j].x); e[j].y = __builtin_amdgcn_rcpf(e[j].y); }
#pragma unroll
                    for (int j = 0; j < 4; ++j) v[j] = x[j] * e[j];
                    v4u w; w.x = pk2(v[0].x, v[0].y); w.y = pk2(v[1].x, v[1].y); w.z = pk2(v[2].x, v[2].y); w.w = pk2(v[3].x, v[3].y);
                    if (seg == 0) *(LAS v4u*)(rbase + i * XPI) = w;
                    else {
                        *(LAS v4u*)(rbase + i * TPI) = w;
                        if (seg == 1) {
                            const float wsv = wbase[i] * exp_f(aend - abase[i]);
                            const f32x2 a0 = v[0] * wsv, a1 = v[1] * wsv, a2 = v[2] * wsv, a3 = v[3] * wsv;
                            v4u w2; w2.x = pk2(a0.x, a0.y); w2.y = pk2(a1.x, a1.y); w2.z = pk2(a2.x, a2.y); w2.w = pk2(a3.x, a3.y);
                            *(LAS v4u*)(r2base + i * TPI) = w2;
                        }
                    }
                }
                __builtin_amdgcn_sched_barrier(0);
            }
#undef CVP
        }
        v2u zz[4];
#pragma unroll
        for (int n = 0; n < 4; ++n) zz[n] = *(const v2u*)(ZX + (size_t)(row0 + trow) * ZXP + h * 64 + n * 16 + fq * 4);
        unsigned pd0, pd1;
        {
            const int nrow0 = (c < 15 ? row0 + 128 : row0);
            const int li0 = tid, li1 = tid < 256 ? tid + 512 : tid;
            const int ra = li0 / 6, ka = li0 % 6, rb = li1 / 6, kb = li1 % 6;
            const int oa = ka == 0 ? h * 64 : (ka == 1 ? 2048 + h * 64 : (ka < 4 ? 4096 + g * 128 + (ka - 2) * 64 : 5120 + g * 128 + (ka - 4) * 64));
            const int ob = kb == 0 ? h * 64 : (kb == 1 ? 2048 + h * 64 : (kb < 4 ? 4096 + g * 128 + (kb - 2) * 64 : 5120 + g * 128 + (kb - 4) * 64));
            const bf16* pa = ZX + (size_t)(nrow0 + ra) * ZXP + oa; const bf16* pb = ZX + (size_t)(nrow0 + rb) * ZXP + ob;
            pd0 = *(const unsigned*)pa;
            pd1 = *(const unsigned*)pb;
        }
        LDS_BARRIER();
        {
            f32x4 cbv[4][2];
#pragma unroll
            for (int m = 0; m < 4; ++m)
#pragma unroll
                for (int n = 0; n < 2; ++n) cbv[m][n] = (f32x4){0.f, 0.f, 0.f, 0.f};
#pragma unroll
            for (int k0 = 0; k0 < 128; k0 += 32) {
                bf16x8 af[4], bfr[2];
#pragma unroll
                for (int m = 0; m < 4; ++m) af[m] = *(const LAS bf16x8*)(CM + (wr * 64 + m * 16 + fr) * TPI + k0 + fq * 8);
#pragma unroll
                for (int n = 0; n < 2; ++n) bfr[n] = *(const LAS bf16x8*)(BM + (wc * 32 + n * 16 + fr) * TPI + k0 + fq * 8);
#pragma unroll
                for (int m = 0; m < 4; ++m)
#pragma unroll
                    for (int n = 0; n < 2; ++n) cbv[m][n] = MFMA16(bfr[n], af[m], cbv[m][n]);
            }
            LDS_BARRIER();
#pragma unroll
            for (int m = 0; m < 4; ++m) {
                const int t = wr * 64 + m * 16 + fr; const float at = ACUM[t];
#pragma unroll
                for (int n = 0; n < 2; ++n) {
                    const int s0 = wc * 32 + n * 16 + fq * 4;
                    v2u w; w.x = 0u; w.y = 0u;
                    if (wc * 2 + n <= wr * 4 + m) {
                        float mv[4];
#pragma unroll
                        for (int j = 0; j < 4; ++j) { const int s = s0 + j; mv[j] = (s <= t) ? cbv[m][n][j] * exp_f(at - ACUM[s]) * DTS[s] : 0.f; }
                        w.x = pk2(mv[0], mv[1]); w.y = pk2(mv[2], mv[3]);
                    }
                    *(LAS v2u*)(BM + t * TPI + s0) = w;
                }
            }
            LDS_BARRIER();
        }
        {
            f32x4 yd[4], yo[4];
#pragma unroll
            for (int n = 0; n < 4; ++n) { yd[n] = (f32x4){0.f, 0.f, 0.f, 0.f}; yo[n] = (f32x4){0.f, 0.f, 0.f, 0.f}; }
#pragma unroll
            for (int k0 = 0; k0 < 128; k0 += 32) {
                if (k0 <= wid * 16 + 15) {
                    const bf16x8 am = *(const LAS bf16x8*)(BM + trow * TPI + k0 + fq * 8);
#pragma unroll
                    for (int n = 0; n < 4; ++n) { const bf16x8 bx = tr_frag(XST, XPI, k0, n, lane); yd[n] = MFMA16(bx, am, yd[n]); }
                }
                const bf16x8 ac = *(const LAS bf16x8*)(CM + trow * TPI + k0 + fq * 8);
#pragma unroll
                for (int n = 0; n < 4; ++n) { const bf16x8 bs = *(const LAS bf16x8*)(STB + (n * 16 + fr) * LP + k0 + fq * 8); yo[n] = MFMA16(bs, ac, yo[n]); }
            }
            const int row = row0 + trow; const float ea = exp_f(ACUM[trow]);
            float ssq = 0.f;
#pragma unroll
            for (int n = 0; n < 4; ++n) {
                const int p0 = n * 16 + fq * 4;
                const v2u xv = *(const LAS v2u*)(XST + trow * XPI + p0);
                const f32x2 z01 = (f32x2){bf_lo(zz[n].x), bf_hi(zz[n].x)}, z23 = (f32x2){bf_lo(zz[n].y), bf_hi(zz[n].y)};
                f32x2 y01 = (f32x2){yo[n][0], yo[n][1]} * ea, y23 = (f32x2){yo[n][2], yo[n][3]} * ea;
                f32x2 e01 = z01 * (-1.4426950409f), e23 = z23 * (-1.4426950409f);
                y01 = y01 + (f32x2){yd[n][0], yd[n][1]}; y23 = y23 + (f32x2){yd[n][2], yd[n][3]};
                e01.x = __builtin_amdgcn_exp2f(e01.x); e01.y = __builtin_amdgcn_exp2f(e01.y); e23.x = __builtin_amdgcn_exp2f(e23.x); e23.y = __builtin_amdgcn_exp2f(e23.y);
                y01 = y01 + (f32x2){bf_lo(xv.x), bf_hi(xv.x)} * D_h; y23 = y23 + (f32x2){bf_lo(xv.y), bf_hi(xv.y)} * D_h;
                e01 = e01 + 1.0f; e23 = e23 + 1.0f;
                e01.x = __builtin_amdgcn_rcpf(e01.x); e01.y = __builtin_amdgcn_rcpf(e01.y); e23.x = __builtin_amdgcn_rcpf(e23.x); e23.y = __builtin_amdgcn_rcpf(e23.y);
                e01 = e01 * z01; e23 = e23 * z23;
                y01 = y01 * e01; y23 = y23 * e23;
                const f32x2 q2 = y01 * y01 + y23 * y23;
                ssq += q2.x + q2.y;
                v2u w; w.x = pk2(y01.x, y01.y); w.y = pk2(y23.x, y23.y);
                *(v2u*)(G + (size_t)row * DIN + h * 64 + p0) = w;
            }
            ssq += __shfl_xor(ssq, 16); ssq += __shfl_xor(ssq, 32);
            if (fq == 0) SS[(size_t)row * 32 + h] = ssq;
        }
        {
            const float dec = exp_f(aend);
#pragma unroll
            for (int m = 0; m < 4; ++m) st[m] = st[m] * dec;
#pragma unroll
            for (int k0 = 0; k0 < 128; k0 += 32) {
                const bf16x8 bw = tr_frag(BWT, TPI, k0, wid, lane);
#pragma unroll
                for (int m = 0; m < 4; ++m) { const bf16x8 ax = tr_frag(XST, XPI, k0, m, lane); st[m] = MFMA16(bw, ax, st[m]); }
            }
        }
        asm volatile("" :: "v"(pd0), "v"(pd1));
        LDS_BARRIER();
    }
#undef SSD_ISSUE
#undef SSD_DT
    if (tid < 120) {
        const int r = tid / 40;
        float v[8]; cv8(*(const v4u*)(ZX + (size_t)(b * 2048 + 2045 + r) * ZXP + 2048 + ch0), v);
        float* o = a.out + O_CP + (size_t)(b * 3 + r) * 4096 + ch0;
        *(f32x4*)o = (f32x4){v[0], v[1], v[2], v[3]}; *(f32x4*)(o + 4) = (f32x4){v[4], v[5], v[6], v[7]};
    }
    float* so = a.out + O_SP + (size_t)(b * 32 + h) * 8192;
#pragma unroll
    for (int m = 0; m < 4; ++m) __builtin_nontemporal_store(st[m], (f32x4*)(so + (m * 16 + fr) * 128 + wid * 16 + fq * 4));
}

constexpr int S_RAW = 0, S_XS = 14080, S_BM = 16128, S_CM = 20224, S_DT = 24320, S_MM = 24416, S_YS = 24672, S_SLOT = 26752, S_CW = 2 * S_SLOT;
__device__ __forceinline__ int ssd_chan(int cc, int h, int g) { return cc < 64 ? h * 64 + cc : (cc < 192 ? 2048 + g * 128 + (cc - 64) : 3072 + g * 128 + (cc - 192)); }
__device__ __forceinline__ void ssd_sample_units(CArgs& a, ldsp lds, int bid, int G_, int tid) {
    const int lane = tid & 63, wid = tid >> 6;
    const bf16* ZX = (const bf16*)(a.ws + WS_BIG); bf16* G = (bf16*)(a.ws + WS_G); const float* DT = (const float*)(a.ws + WS_DT); float* SS = (float*)(a.ws + WS_SS);
    LAS float* CW = (LAS float*)(lds + S_CW);
    const float* sconv = a.in[5];
    const int p = tid >> 3, q = tid & 7, n0 = q * 16;
    int hc = -1;
    float A_h = 0.f, D_h = 0.f, dtb = 0.f;
    f32x4 s0[2][4]; float cv0[2] = {0.f, 0.f}, cv1[2] = {0.f, 0.f}; unsigned short zb[2][7] = {{0, 0, 0, 0, 0, 0, 0}, {0, 0, 0, 0, 0, 0, 0}}; float dtv[2] = {0.f, 0.f}; unsigned short zvb[2] = {0, 0};
#define SMP_ISSUE(j_, u_) do { const int bs_ = (u_) >> 5, h_ = (u_) & 31, g_ = h_ >> 2, r0_ = TP + bs_ * 8; \
        const float* sp_ = a.in[4] + ((size_t)(bs_ * 32 + h_) * 64 + p) * 128 + n0; \
        _Pragma("unroll") for (int i_ = 0; i_ < 4; ++i_) s0[j_][i_] = *(const f32x4*)(sp_ + 4 * i_); \
        { const int e_ = tid; cv0[j_] = sconv[(size_t)(bs_ * 3 + e_ / 320) * 4096 + ssd_chan(e_ % 320, h_, g_)]; } \
        { const int e_ = tid + NTHR, rr_ = e_ / 320, ch_ = ssd_chan(e_ % 320, h_, g_); \
          if (e_ < 960) cv1[j_] = sconv[(size_t)(bs_ * 3 + rr_) * 4096 + ch_]; else zb[j_][1] = ZX[(size_t)(r0_ + rr_ - 3) * ZXP + 2048 + ch_]; } \
        _Pragma("unroll") for (int i_ = 2; i_ < 7; ++i_) { const int e_ = tid + i_ * NTHR; \
            if (e_ < 11 * 320) zb[j_][i_] = ZX[(size_t)(r0_ + e_ / 320 - 3) * ZXP + 2048 + ssd_chan(e_ % 320, h_, g_)]; } \
        if (tid < 8) dtv[j_] = DT[(size_t)(r0_ + tid) * 32 + h_]; \
        zvb[j_] = ZX[(size_t)(r0_ + q) * ZXP + h_ * 64 + p]; } while (0)
    int u = bid;
    if (u < 4096) { SMP_ISSUE(0, u); if (u + G_ < 4096) SMP_ISSUE(1, u + G_); }
    for (; u < 4096; u += 2 * G_) {
        const int nu = (u + G_ < 4096) ? 2 : 1;
        const int h = u & 31, g = h >> 2;
        const int h1 = (u + G_) & 31;
        if (h != hc || (nu == 2 && h1 != h)) {
            LDS_BARRIER();
            A_h = -expf(a.in[20][h]); D_h = a.in[21][h]; dtb = a.in[19][h];
            const float* conv_w = a.in[17]; const float* conv_b = a.in[18];
            for (int i = tid; i < 5 * 320; i += NTHR) { const int k = i / 320, cc = i % 320, ch = ssd_chan(cc, h, g); CW[i] = k < 4 ? conv_w[k * 4096 + ch] : conv_b[ch]; }
            hc = h;
        }
        float rv[2][7]; f32x4 sc[2][4]; float zc[2];
#pragma unroll
        for (int j = 0; j < 2; ++j) {
            LAS float* RAW = (LAS float*)(lds + j * S_SLOT + S_RAW); LAS float* DTs = (LAS float*)(lds + j * S_SLOT + S_DT);
#pragma unroll
            for (int i = 0; i < 7; ++i) { const int e = tid + i * NTHR; rv[j][i] = i == 0 ? cv0[j] : (i == 1 && e < 960 ? cv1[j] : bf1(zb[j][i])); }
#pragma unroll
            for (int i = 0; i < 7; ++i) { const int e = tid + i * NTHR; if (e < 11 * 320) RAW[e] = rv[j][i]; }
            if (tid < 8) DTs[tid] = softplus_f(dtv[j] + dtb);
#pragma unroll
            for (int i = 0; i < 4; ++i) sc[j][i] = s0[j][i];
            zc[j] = bf1(zvb[j]);
        }
        LDS_BARRIER();
        if (u + 2 * G_ < 4096) { SMP_ISSUE(0, u + 2 * G_); if (u + 3 * G_ < 4096) SMP_ISSUE(1, u + 3 * G_); }
        float dts[2][8], acs[2][8];
#pragma unroll
        for (int j = 0; j < 2; ++j) {
            LAS float* DTs = (LAS float*)(lds + j * S_SLOT + S_DT);
            float ac = 0.f;
#pragma unroll
            for (int t = 0; t < 8; ++t) { dts[j][t] = DTs[t]; ac += dts[j][t] * A_h; acs[j][t] = ac; }
        }
#pragma unroll
        for (int j = 0; j < 2; ++j) {
            LAS float* RAW = (LAS float*)(lds + j * S_SLOT + S_RAW); LAS float* XS = (LAS float*)(lds + j * S_SLOT + S_XS); LAS float* BMs = (LAS float*)(lds + j * S_SLOT + S_BM); LAS float* CMs = (LAS float*)(lds + j * S_SLOT + S_CM);
#pragma unroll
            for (int i = 0; i < 5; ++i) {
                const int e = tid + i * NTHR, t = e / 320, cc = e % 320;
                float v = CW[4 * 320 + cc];
#pragma unroll
                for (int k = 0; k < 4; ++k) v += RAW[(t + k) * 320 + cc] * CW[k * 320 + cc];
                v = silu_f(v);
                if (cc < 64) XS[t * 64 + cc] = v; else if (cc < 192) BMs[t * 128 + cc - 64] = v; else CMs[t * 128 + cc - 192] = v;
            }
        }
        LDS_BARRIER();
#pragma unroll
        for (int j = 0; j < 2; ++j) if (j < nu) {
            const int uu = u + j * G_, bsq = uu >> 5;
            LAS float* XS = (LAS float*)(lds + j * S_SLOT + S_XS); LAS float* BMs = (LAS float*)(lds + j * S_SLOT + S_BM); LAS float* CMs = (LAS float*)(lds + j * S_SLOT + S_CM); LAS float* MM = (LAS float*)(lds + j * S_SLOT + S_MM);
            const float aend = acs[j][7];
#pragma unroll
            for (int i = 5; i < 7; ++i) { const int e = tid + i * NTHR; if (e >= 8 * 320 && e < 11 * 320) a.out[O_CSS + (size_t)(bsq * 3 + e / 320 - 8) * 4096 + ssd_chan(e % 320, h, g)] = rv[j][i]; }
            {
                const float dec = exp_f(aend);
                f32x4 ns[4];
#pragma unroll
                for (int i = 0; i < 4; ++i) ns[i] = sc[j][i] * dec;
#pragma unroll
                for (int s = 0; s < 8; ++s) {
                    const float xw = XS[s * 64 + p] * dts[j][s] * exp_f(aend - acs[j][s]);
#pragma unroll
                    for (int i = 0; i < 4; ++i) { const f32x4 bv = *(const LAS f32x4*)(BMs + s * 128 + n0 + 4 * i); ns[i] += xw * bv; }
                }
                float* so = a.out + O_SSS + ((size_t)(bsq * 32 + h) * 64 + p) * 128 + n0;
#pragma unroll
                for (int i = 0; i < 4; ++i) __builtin_nontemporal_store(ns[i], (f32x4*)(so + 4 * i));
            }
            {
                const int pr = tid >> 3, t = pr >> 3, s = pr & 7;
                float cbv = 0.f;
#pragma unroll
                for (int i = 0; i < 4; ++i) { const f32x4 cv = *(const LAS f32x4*)(CMs + t * 128 + n0 + 4 * i), bv = *(const LAS f32x4*)(BMs + s * 128 + n0 + 4 * i); cbv += (cv[0] * bv[0] + cv[1] * bv[1]) + (cv[2] * bv[2] + cv[3] * bv[3]); }
                cbv += __shfl_xor(cbv, 1); cbv += __shfl_xor(cbv, 2); cbv += __shfl_xor(cbv, 4);
                float at = 0.f, as = 0.f, ds = 0.f;
#pragma unroll
                for (int k = 0; k < 8; ++k) { at = (t == k) ? acs[j][k] : at; as = (s == k) ? acs[j][k] : as; ds = (s == k) ? dts[j][k] : ds; }
                if (q == 0) MM[pr] = (s <= t) ? cbv * exp_f(at - as) * ds : 0.f;
            }
        }
        LDS_BARRIER();
#pragma unroll
        for (int j = 0; j < 2; ++j) if (j < nu) {
            LAS float* XS = (LAS float*)(lds + j * S_SLOT + S_XS); LAS float* CMs = (LAS float*)(lds + j * S_SLOT + S_CM); LAS float* MM = (LAS float*)(lds + j * S_SLOT + S_MM); LAS float* YS = (LAS float*)(lds + j * S_SLOT + S_YS);
            float mine = 0.f;
#pragma unroll
            for (int t = 0; t < 8; ++t) {
                float pt = 0.f;
#pragma unroll
                for (int i = 0; i < 4; ++i) { const f32x4 cv = *(const LAS f32x4*)(CMs + t * 128 + n0 + 4 * i); pt += (cv[0] * sc[j][i][0] + cv[1] * sc[j][i][1]) + (cv[2] * sc[j][i][2] + cv[3] * sc[j][i][3]); }
                pt += __shfl_xor(pt, 1); pt += __shfl_xor(pt, 2); pt += __shfl_xor(pt, 4);
                mine = (q == t) ? pt : mine;
            }
            float aq = 0.f;
#pragma unroll
            for (int k = 0; k < 8; ++k) aq = (q == k) ? acs[j][k] : aq;
            float y = exp_f(aq) * mine + D_h * XS[q * 64 + p];
#pragma unroll
            for (int s = 0; s < 8; ++s) y += MM[q * 8 + s] * XS[s * 64 + p];
            YS[q * 64 + p] = y * silu_f(zc[j]);
        }
        LDS_BARRIER();
#pragma unroll
        for (int j = 0; j < 2; ++j) if (j < nu) {
            const int uu = u + j * G_, row0 = TP + (uu >> 5) * 8;
            LAS float* YS = (LAS float*)(lds + j * S_SLOT + S_YS);
            const int t = wid; const float y = YS[t * 64 + lane];
            G[(size_t)(row0 + t) * DIN + h * 64 + lane] = (bf16)f2bf(y);
            const float ssq = wave_sum(y * y);
            if (lane == 0) SS[(size_t)(row0 + t) * 32 + h] = ssq;
        }
    }
#undef SMP_ISSUE
    LDS_BARRIER();
}
#define XB_TMO      128
#define XB_XCNT(j)  (256  + 64 * (j))
#define XB_XSUB(j)  (1280 + 64 * (j))
#define XB_XGEN(j)  (2304 + 64 * (j))
#define XB_TOP      3328
#define XB_TOPGEN   3392
#define XCD_BAR_WORDS 3456
#define XB_SPIN_CAP (1u << 18)

__device__ __forceinline__ unsigned xb_ld(unsigned* p)              { return __hip_atomic_load(p, __ATOMIC_RELAXED, __HIP_MEMORY_SCOPE_AGENT); }
__device__ __forceinline__ unsigned xb_add(unsigned* p, unsigned v) { return __hip_atomic_fetch_add(p, v, __ATOMIC_RELAXED, __HIP_MEMORY_SCOPE_AGENT); }
__device__ __forceinline__ unsigned xb_xcc_id() { return (unsigned)__builtin_amdgcn_s_getreg((3 << 11) | 20) & 0xFu; }
#define XB_SPIN(cond, bar) do { unsigned _sp = 0; while (cond) { __builtin_amdgcn_s_sleep(1); \
    if ((++_sp & 255u) == 0u) { if (xb_ld(&(bar)[XB_TMO])) break; if (_sp > XB_SPIN_CAP) { atomicAdd(&(bar)[XB_TMO], 1u); break; } } } } while (0)

struct XcdBarrier {
    unsigned* bar; unsigned x;
    volatile LAS unsigned* st;
};

__device__ __forceinline__ XcdBarrier xcd_barrier_post(unsigned* bar, volatile LAS unsigned* st) {
    XcdBarrier b; b.bar = bar; b.x = xb_xcc_id(); b.st = st;
    if (threadIdx.x == 0) (void)xb_add(&bar[XB_XCNT(b.x)], 1u);
    return b;
}
__device__ __forceinline__ void xcd_barrier_complete(unsigned* bar, unsigned x, unsigned& nloc, unsigned& nx) {
    const unsigned G = gridDim.x * gridDim.y * gridDim.z;
    unsigned sum, cnt, mine, sp = 0u;
    for (;;) {
        sum = 0u; cnt = 0u; mine = 0u;
#pragma unroll
        for (unsigned j = 0; j < 16; ++j) { const unsigned c = xb_ld(&bar[XB_XCNT(j)]); sum += c; cnt += (c > 0u) ? 1u : 0u; mine = (j == x) ? c : mine; }
        if (sum == G) break;
        __builtin_amdgcn_s_sleep(1);
        if ((++sp & 255u) == 0u) { if (xb_ld(&bar[XB_TMO])) break; if (sp > XB_SPIN_CAP) { atomicAdd(&bar[XB_TMO], 1u); break; } }
    }
    nloc = mine > 0u ? mine : 1u; nx = cnt > 0u ? cnt : 1u;
}

__device__ __forceinline__ void xcd_barrier(const XcdBarrier& b) {
    asm volatile("s_waitcnt vmcnt(0)" ::: "memory");
    __syncthreads();
    if (threadIdx.x == 0) {
        unsigned* bar = b.bar;
        __builtin_amdgcn_s_waitcnt(0);
        unsigned nloc = b.st[0], nx = b.st[1];
        if (nloc == 0u) { xcd_barrier_complete(bar, b.x, nloc, nx); b.st[0] = nloc; b.st[1] = nx; }
        const unsigned old = xb_add(&bar[XB_XSUB(b.x)], 1u);
        const unsigned gen = old / nloc;
        if (old + 1u == (gen + 1u) * nloc) {
            __builtin_amdgcn_fence(__ATOMIC_RELEASE, "agent");
            asm volatile("s_waitcnt vmcnt(0)" ::: "memory");
            const unsigned og = xb_add(&bar[XB_TOP], 1u);
            const unsigned tg = og / nx;
            if (og + 1u == (tg + 1u) * nx) xb_add(&bar[XB_TOPGEN], 1u);
            else XB_SPIN(xb_ld(&bar[XB_TOPGEN]) == tg, bar);
            __builtin_amdgcn_fence(__ATOMIC_ACQUIRE, "agent");
            xb_add(&bar[XB_XGEN(b.x)], 1u);
            asm volatile("s_waitcnt vmcnt(0)" ::: "memory");
        } else {
            XB_SPIN(xb_ld(&bar[XB_XGEN(b.x)]) == gen, bar);
            __builtin_amdgcn_fence(__ATOMIC_ACQUIRE, "agent");
            asm volatile("s_waitcnt vmcnt(0)" ::: "memory");
        }
    }
    __syncthreads();
}

#ifndef PROBE
#define PROBE -1
#endif
#if PROBE == 12
#define PROBE12_EXTRA { int tid3 = threadIdx.x; asm volatile("" : "+v"(tid3)); ssd_sample_units(a, lds, bid, G_, tid3); }
#else
#define PROBE12_EXTRA
#endif
constexpr int NPH = 18;
__global__ void __launch_bounds__(NTHR, 2) mk_fwd(Args a_) {
    extern __shared__ __attribute__((aligned(16))) unsigned char lds_raw[];
    cg::grid_group grid = cg::this_grid();
    ldsp lds = (ldsp)lds_raw;
    const int ph_lo = a_.ph_lo, ph_hi = a_.ph_hi;
    volatile LAS unsigned* MISC = (volatile LAS unsigned*)(lds + MISC_OFF);
    if (threadIdx.x < 16) MISC[threadIdx.x] = 0u;
    __syncthreads();
    (void)xcd_barrier_post((unsigned*)(a_.ws + WS_CTL), MISC + 8);
#define PH_BEGIN(k) if (ph_lo <= (k) && (k) < ph_hi) { \
        CArgs* ap = (CArgs*)__builtin_amdgcn_kernarg_segment_ptr(); asm volatile("" : "+s"(ap)); CArgs& a = *ap; \
        int tid = threadIdx.x; asm volatile("" : "+v"(tid)); int G_ = gridDim.x, bid = blockIdx.x; asm volatile("" : "+s"(G_), "+s"(bid)); \
        const int lane = tid & 63, wave = __builtin_amdgcn_readfirstlane(tid >> 6), gw = bid * NWAVES + wave, NGW = G_ * NWAVES; (void)lane; (void)gw; (void)NGW; \
        unsigned char* ws = a.ws; float* XR = a.out + O_Y; const float* MOD = (const float*)(ws + WS_MOD); (void)XR; (void)MOD; \
        bf16* H = (bf16*)(ws + WS_H); bf16* BIG = (bf16*)(ws + WS_BIG); bf16* GB = (bf16*)(ws + WS_G); (void)H; (void)BIG; (void)GB;
#define PH_END(k) if ((k) + 1 < ph_hi) { if (ph_hi > 1000) grid.sync(); else { XcdBarrier bar; bar.bar = (unsigned*)(ws + WS_CTL); bar.x = xb_xcc_id(); bar.st = (volatile LAS unsigned*)(lds + MISC_OFF) + 8; xcd_barrier(bar); } } }
#define RUN_GEMM() do { pg8::StaticOrder S; S.init(gm.M, gm.N, G_, bid); pg8::gemm_phase<pg8::EpiGen, pg8::StaticOrder, true, true>(lds, gm, S, E); } while (0)
#define EPI0 pg8::EpiGen E{0, 0, nullptr, 0, nullptr, nullptr, nullptr}
#define RUN_RES_GEMM(Aptr, Wptr, KK, GATE, MODE1, BASE) do { \
        { pg8::Gemm gm{(Aptr), (Wptr), TP, 1024, (KK), (KK)}; EPI0; E.mode = (MODE1); E.F = XR; E.aux = (GATE); E.aux2 = const_cast<float*>(BASE); pg8::StaticOrder S; S.init(TP, 1024, G_, bid, 0, 1); pg8::gemm_phase<pg8::EpiGen, pg8::StaticOrder, true, true>(lds, gm, S, E); } \
        { pg8::Gemm gm{(Aptr), (Wptr), TS, 1024, (KK) / NSPLIT, (KK)}; EPI0; E.mode = 3; E.F = (float*)(ws + WS_PART); E.aux = (GATE); pg8::StaticOrder S; S.init(TS, 1024, G_, bid, TP / 256, NSPLIT); pg8::gemm_phase<pg8::EpiGen, pg8::StaticOrder, true, true>(lds, gm, S, E); } } while (0)

    PH_BEGIN(0) p0_prologue(a, lds, 0, 2 * I_ADA, gw, NGW, true, wave, lane); PH_END(0)
    PH_BEGIN(1) { pg8::Gemm gm{(const bf16*)(ws + WS_CS), (const bf16*)(ws + WS_WADA), 256, NMODC, 1024, 1024}; EPI0; E.mode = 2; E.F = (float*)(ws + WS_MOD); E.aux = a.in[7]; RUN_GEMM(); }
                { const int nb_ = (NMODC / 256) < G_ ? (NMODC / 256) : 0; if (bid >= nb_) { const int w_ = gw - nb_ * NWAVES, nw_ = NGW - nb_ * NWAVES;
                    p0_prologue(a, lds, IT_GIN, IT_SIN, w_, nw_, false, wave, lane); p0_prologue(a, lds, IT_M1A, IT_M1B, w_, nw_, false, wave, lane); p0_prologue(a, lds, IT_M2A, IT_M2B, w_, nw_, false, wave, lane); } } PH_END(1)
    PH_BEGIN(2) normmod_phase(a.in[0], a.in[1], a.in[8], MOD + 0, MOD + 1024, H, XR, nullptr, gw, NGW, lane); PH_END(2)
    PH_BEGIN(3) { pg8::Gemm gm{H, (const bf16*)(ws + WS_WGIN), T, 4096, 1024, 1024}; EPI0; E.mode = 16; E.act = 1; E.O = BIG; E.ldc = 4096; E.aux2 = (float*)(ws + WS_STATS); RUN_GEMM(); }
                { const int nb_ = (T / 256 * 16) % G_; if (nb_ > 0 && bid >= nb_) p0_prologue(a, lds, IT_SIN, IT_M1A, gw - nb_ * NWAVES, NGW - nb_ * NWAVES, false, wave, lane); else if (nb_ == 0) p0_prologue(a, lds, IT_SIN, IT_M1A, gw, NGW, false, wave, lane); } PH_END(3)
    PH_BEGIN(4) for (int rep = 0; rep < (PROBE == 4 ? 2 : 1); ++rep) for (int u = bid; u < 1024 + 128; u += G_) { if (u < 1024) gate_prompt_unit(a, lds, u, tid); else gate_sample_unit(a, u - 1024, tid); } PH_END(4)
    PH_BEGIN(5) RUN_RES_GEMM(GB, (const bf16*)(ws + WS_WGOUT), 2048, MOD + 2048, 5, a.in[0]); PH_END(5)
    PH_BEGIN(6) normmod_phase(XR, XR + (size_t)TP * D, a.in[9], MOD + 3072, MOD + 4096, H, nullptr, (const float*)(ws + WS_PART), gw, NGW, lane); PH_END(6)
    PH_BEGIN(7) { pg8::Gemm gm{H, (const bf16*)(ws + WS_WM1), T, 4096, 1024, 1024}; EPI0; E.mode = 0; E.act = 2; E.O = BIG; E.ldc = 4096; RUN_GEMM(); }
                { const int nb_ = (T / 256 * 16) % G_; const int w_ = nb_ > 0 ? gw - nb_ * NWAVES : gw, nw_ = nb_ > 0 ? NGW - nb_ * NWAVES : NGW;
                  if (nb_ == 0 || bid >= nb_) { p0_prologue(a, lds, IT_M1B, IT_M2A, w_, nw_, false, wave, lane); p0_prologue(a, lds, IT_M2B, NITEMS, w_, nw_, false, wave, lane); } } PH_END(7)
    PH_BEGIN(8) RUN_RES_GEMM(BIG, (const bf16*)(ws + WS_WM2), 4096, MOD + 5120, 1, (const float*)nullptr); PH_END(8)
    PH_BEGIN(9) normmod_phase(XR, XR + (size_t)TP * D, a.in[8] + 1024, MOD + 6144, MOD + 6144 + 1024, H, nullptr, (const float*)(ws + WS_PART), gw, NGW, lane); PH_END(9)
    PH_BEGIN(10) { pg8::Gemm gm{H, (const bf16*)(ws + WS_WSIN), T, NPROJ_PAD, 1024, 1024}; EPI0; E.mode = 32; E.act = 0; E.O = BIG; E.ldc = ZXP; E.aux2 = (float*)(ws + WS_DT); RUN_GEMM(); } PH_END(10)
    PH_BEGIN(11) { for (int u = bid; u < 256; u += G_) { const int xg = u & 7, sl = u >> 3; ssd_prompt_unit(a, lds, sl >> 2, xg * 4 + (sl & 3), tid); }     int tid2 = threadIdx.x; asm volatile("" : "+v"(tid2)); ssd_sample_units(a, lds, bid, G_, tid2); PROBE12_EXTRA } PH_END(11)
    PH_BEGIN(12) groupnorm_phase(GB, (const float*)(ws + WS_SS), gw, NGW, lane); PH_END(12)
    PH_BEGIN(13) RUN_RES_GEMM(GB, (const bf16*)(ws + WS_WSOUT), 2048, MOD + 6144 + 2048, 1, (const float*)nullptr); PH_END(13)
    PH_BEGIN(14) normmod_phase(XR, XR + (size_t)TP * D, a.in[9] + 1024, MOD + 6144 + 3072, MOD + 6144 + 4096, H, nullptr, (const float*)(ws + WS_PART), gw, NGW, lane); PH_END(14)
    PH_BEGIN(15) { pg8::Gemm gm{H, (const bf16*)(ws + WS_WM1) + (size_t)4096 * 1024, T, 4096, 1024, 1024}; EPI0; E.mode = 0; E.act = 2; E.O = BIG; E.ldc = 4096; RUN_GEMM(); } PH_END(15)
    PH_BEGIN(16) RUN_RES_GEMM(BIG, (const bf16*)(ws + WS_WM2) + (size_t)1024 * 4096, 4096, MOD + 6144 + 5120, 1, (const float*)nullptr); PH_END(16)
    PH_BEGIN(17) finalnorm_phase(XR, a.in[26], (const float*)(ws + WS_PART), gw, NGW, lane); PH_END(17)
}

#ifndef MK_PER_PHASE
#define MK_PER_PHASE 0
#endif
extern "C" void kernel_launch(void* const* d_in, const int* in_sizes, int n_in, void* d_out, int out_size, void* d_ws, size_t ws_size, hipStream_t stream) {
    static int grid = 0;
    if (grid == 0) {
        if (n_in != 27 || (size_t)out_size != O_END || ws_size < WS_END) { fprintf(stderr, "kernel_launch: unexpected shapes: n_in %d out %d ws %zu (need %zu)\n", n_in, out_size, ws_size, (size_t)WS_END); grid = -1; return; }
        int dev = 0, cus = 0, per_cu = 0;
        if (hipGetDevice(&dev) != hipSuccess || hipDeviceGetAttribute(&cus, hipDeviceAttributeMultiprocessorCount, dev) != hipSuccess) { grid = -1; return; }
        if (hipFuncSetAttribute((const void*)mk_fwd, hipFuncAttributeMaxDynamicSharedMemorySize, LDS_BYTES) != hipSuccess) { fprintf(stderr, "kernel_launch: hipFuncSetAttribute failed\n"); grid = -1; return; }
        if (hipOccupancyMaxActiveBlocksPerMultiprocessor(&per_cu, (const void*)mk_fwd, NTHR, LDS_BYTES) != hipSuccess || per_cu < 1) { fprintf(stderr, "kernel_launch: occupancy query says %d\n", per_cu); per_cu = 1; }
        (void)hipGetLastError();
        grid = cus * 1;
    }
    if (grid < 0) return;
    if (hipMemsetAsync((char*)d_ws + WS_CTL, 0, CTL_BYTES, stream) != hipSuccess) { fprintf(stderr, "kernel_launch: memset of the control words failed\n"); return; }
    Args a{};
    for (int i = 0; i < 27; ++i) a.in[i] = (const float*)d_in[i];
    a.out = (float*)d_out; a.ws = (unsigned char*)d_ws;
#if MK_PER_PHASE
    for (int ph = 0; ph < NPH; ++ph) {
        a.ph_lo = ph; a.ph_hi = ph + 1;
        hipLaunchKernelGGL(mk_fwd, dim3(grid), dim3(NTHR), LDS_BYTES, stream, a);
    }
#else
    a.ph_lo = 0; a.ph_hi = NPH;
    void* args[] = {&a};
    hipError_t e = hipLaunchCooperativeKernel((const void*)mk_fwd, dim3(grid), dim3(NTHR), args, LDS_BYTES, stream);
    if (e != hipSuccess) fprintf(stderr, "kernel_launch: cooperative launch failed: %s (grid %d)\n", hipGetErrorString(e), grid);
#endif
}
```
